# Optimizing an MI355X kernel written in HIP

```python
import jax, jax.numpy as jnp
from jax import lax
import numpy as np

D_MODEL = 2048
BATCH = 2
SEQ = 4096
DEPTH = 4

ATTN_WIDTH = D_MODEL // 2
HEAD_DIM_ATTN = 128
N_HEADS_ATTN = ATTN_WIDTH // HEAD_DIM_ATTN
DILATION_PATTERNS = ((128, 1), (512, 4), (2048, 16))
RET_WIDTH = D_MODEL // 2
N_HEADS_RET = 4
RET_V_DIM = RET_WIDTH // N_HEADS_RET
RET_QK_DIM = RET_V_DIM // 2
RET_CHUNK = 128
MIX_WIDTH = ATTN_WIDTH + RET_WIDTH
IN_SPLIT_SIZES = (ATTN_WIDTH, ATTN_WIDTH, ATTN_WIDTH, ATTN_WIDTH,
                  N_HEADS_RET * RET_QK_DIM, N_HEADS_RET * RET_QK_DIM, RET_WIDTH, RET_WIDTH)
IN_PROJ_WIDTH = sum(IN_SPLIT_SIZES)
IN_SPLIT_IDX = tuple(int(i) for i in np.cumsum(IN_SPLIT_SIZES)[:-1])
NORM_EPS = 1e-6
MASK_VALUE = -1e30

kernel_name = "hybrid_dilated_attn_retention_encoder"


def rms_norm(x, g):
    xf = x.astype(jnp.float32)
    y = xf * lax.rsqrt(jnp.mean(xf * xf, axis=-1, keepdims=True) + NORM_EPS)
    return (y * g.astype(jnp.float32)).astype(x.dtype)


def alibi_slopes(n_heads):
    return jnp.exp2(-8.0 * (jnp.arange(n_heads, dtype=jnp.float32) + 1.0) / n_heads)


def dilated_window_attention(q, k, v, window, dilation, slopes):
    b, s, h, e = q.shape
    radius = window // (2 * dilation)
    blk = radius
    sub_len = s // dilation
    n_blk = -(-sub_len // blk)
    pad_len = n_blk * blk
    def to_sub(t):
        return t.reshape(b, sub_len, dilation, h, e)
    qs = jnp.pad(to_sub(q), ((0, 0), (0, pad_len - sub_len), (0, 0), (0, 0), (0, 0)))
    qb = qs.reshape(b, n_blk, blk, dilation, h, e)
    def key_windows(t):
        tp = jnp.pad(to_sub(t), ((0, 0), (blk, blk + pad_len - sub_len), (0, 0), (0, 0), (0, 0)))
        tb = tp.reshape(b, n_blk + 2, blk, dilation, h, e)
        return jnp.concatenate([tb[:, :-2], tb[:, 1:-1], tb[:, 2:]], axis=2)
    kw = key_windows(k)
    vw = key_windows(v)
    scores = jnp.einsum('bnirhe,bnjrhe->bnrhij', qb, kw).astype(jnp.float32)
    i_idx = jnp.arange(blk)[:, None]
    j_idx = jnp.arange(3 * blk)[None, :]
    rel = j_idx - blk - i_idx
    key_pos = jnp.arange(n_blk)[:, None] * blk + jnp.arange(3 * blk)[None, :] - blk
    valid = (key_pos >= 0) & (key_pos < sub_len)
    mask = (jnp.abs(rel) <= radius)[None] & valid[:, None, :]
    dist = (jnp.abs(rel) * dilation).astype(jnp.float32)
    bias = -slopes[:, None, None] * dist[None]
    scores = jnp.where(mask[None, :, None, None], scores + bias[None, None, None], MASK_VALUE)
    m = jnp.max(scores, axis=-1, keepdims=True)
    p = jnp.exp(scores - m)
    den = jnp.sum(p, axis=-1)
    o = jnp.einsum('bnrhij,bnjrhe->bnirhe', p, vw.astype(jnp.float32))
    o = o / den.transpose(0, 1, 4, 2, 3)[..., None]
    lse = (m[..., 0] + jnp.log(den)).transpose(0, 1, 4, 2, 3)
    o = o.reshape(b, pad_len, dilation, h, e)[:, :sub_len].reshape(b, s, h, e)
    lse = lse.reshape(b, pad_len, dilation, h)[:, :sub_len].reshape(b, s, h)
    return o, lse


def dilated_attention_mixture(q, k, v):
    slopes = alibi_slopes(q.shape[2])
    outs, lses = [], []
    for window, dilation in DILATION_PATTERNS:
        o, lse = dilated_window_attention(q, k, v, window, dilation, slopes)
        outs.append(o)
        lses.append(lse)
    w = jax.nn.softmax(jnp.stack(lses, axis=0), axis=0)
    o = jnp.sum(w[..., None] * jnp.stack(outs, axis=0), axis=0)
    return o.astype(v.dtype)


def retention_one_direction(q, k, v, log_gamma):
    b, s, h, dk = q.shape
    dv = v.shape[-1]
    c = RET_CHUNK
    n = s // c
    def chunk(t):
        return t.reshape(b, n, c, h, t.shape[-1]).transpose(1, 0, 3, 2, 4)
    qc, kc, vc = chunk(q), chunk(k), chunk(v)
    idx = jnp.arange(c, dtype=jnp.float32)
    rel = idx[:, None] - idx[None, :]
    lg = log_gamma[:, None, None]
    decay = jnp.where(rel[None] >= 0, jnp.exp(jnp.maximum(rel, 0.0)[None] * lg), 0.0).astype(q.dtype)
    xi = jnp.exp((idx[None] + 1.0) * log_gamma[:, None]).astype(q.dtype)[..., None]
    zeta = jnp.exp((c - 1.0 - idx[None]) * log_gamma[:, None]).astype(q.dtype)[..., None]
    g_chunk = jnp.exp(c * log_gamma).astype(q.dtype)[:, None, None]

    def step(state, inp):
        qi, ki, vi = inp
        inner = jnp.einsum('bhid,bhjd->bhij', qi, ki) * decay
        o = jnp.einsum('bhij,bhje->bhie', inner, vi) + jnp.einsum('bhid,bhde->bhie', qi, state) * xi
        state = state * g_chunk + jnp.einsum('bhjd,bhje->bhde', ki * zeta, vi)
        return state, o

    state0 = jnp.zeros((b, h, dk, dv), dtype=q.dtype)
    _, oc = lax.scan(step, state0, (qc, kc, vc))
    return oc.transpose(1, 0, 3, 2, 4).reshape(b, s, h, dv)


def bidirectional_retention(q, k, v, decay_logit_f, decay_logit_b):
    lg_f = jax.nn.log_sigmoid(decay_logit_f.astype(jnp.float32))
    lg_b = jax.nn.log_sigmoid(decay_logit_b.astype(jnp.float32))
    o_f = retention_one_direction(q, k, v, lg_f)
    o_b = jnp.flip(retention_one_direction(jnp.flip(q, 1), jnp.flip(k, 1), jnp.flip(v, 1), lg_b), 1)
    o = (o_f + o_b).astype(jnp.float32)
    o = o * lax.rsqrt(jnp.mean(o * o, axis=-1, keepdims=True) + NORM_EPS)
    return o.astype(v.dtype)


def hybrid_layer(x, c_act, g, w_ada, b_ada, w_in, w_out, dec_f, dec_b):
    b, s, _ = x.shape
    mod = c_act @ w_ada + b_ada
    shift, scale, gate = jnp.split(mod, 3, axis=-1)
    h = rms_norm(x, g) * (1.0 + scale[:, None]) + shift[:, None]
    proj = jnp.einsum('bsd,df->bsf', h, w_in)
    q_a, k_a, v_a, z_a, q_r, k_r, v_r, z_r = jnp.split(proj, IN_SPLIT_IDX, axis=-1)
    q_a = q_a.reshape(b, s, N_HEADS_ATTN, HEAD_DIM_ATTN) * (HEAD_DIM_ATTN ** -0.5)
    k_a = k_a.reshape(b, s, N_HEADS_ATTN, HEAD_DIM_ATTN)
    v_a = v_a.reshape(b, s, N_HEADS_ATTN, HEAD_DIM_ATTN)
    y_a = dilated_attention_mixture(q_a, k_a, v_a).reshape(b, s, ATTN_WIDTH)
    q_r = q_r.reshape(b, s, N_HEADS_RET, RET_QK_DIM)
    k_r = k_r.reshape(b, s, N_HEADS_RET, RET_QK_DIM) * (RET_QK_DIM ** -0.5)
    v_r = v_r.reshape(b, s, N_HEADS_RET, RET_V_DIM)
    y_r = bidirectional_retention(q_r, k_r, v_r, dec_f, dec_b).reshape(b, s, RET_WIDTH)
    y = jnp.concatenate([y_a * jax.nn.silu(z_a), y_r * jax.nn.silu(z_r)], axis=-1)
    out = jnp.einsum('bsf,fd->bsd', y, w_out)
    return x + gate[:, None] * out


def setup_inputs(seed: int = 0) -> dict:
    key = jax.random.key(seed)
    ks = jax.random.split(key, 10)
    f32 = jnp.float32
    x = jax.random.normal(ks[0], (BATCH, SEQ, D_MODEL), f32)
    c = jax.random.normal(ks[1], (BATCH, D_MODEL), f32)
    norm_gain = 1.0 + 0.02 * jax.random.normal(ks[2], (DEPTH, D_MODEL), f32)
    w_ada = 0.5 * D_MODEL ** -0.5 * jax.random.normal(ks[3], (DEPTH, D_MODEL, 3 * D_MODEL), f32)
    b_ada = 0.02 * jax.random.normal(ks[4], (DEPTH, 3 * D_MODEL), f32)
    w_in = D_MODEL ** -0.5 * jax.random.normal(ks[5], (DEPTH, D_MODEL, IN_PROJ_WIDTH), f32)
    w_out = MIX_WIDTH ** -0.5 * jax.random.normal(ks[6], (DEPTH, MIX_WIDTH, D_MODEL), f32)
    gamma = 1.0 - jnp.exp2(-5.0 - jnp.arange(N_HEADS_RET, dtype=f32))
    base_logit = jnp.log(gamma) - jnp.log1p(-gamma)
    ret_decay_logit_f = base_logit[None] + 0.1 * jax.random.normal(ks[7], (DEPTH, N_HEADS_RET), f32)
    ret_decay_logit_b = base_logit[None] + 0.1 * jax.random.normal(ks[8], (DEPTH, N_HEADS_RET), f32)
    final_gain = 1.0 + 0.02 * jax.random.normal(ks[9], (D_MODEL,), f32)
    return {"x": x, "c": c, "norm_gain": norm_gain, "w_ada": w_ada, "b_ada": b_ada,
            "w_in": w_in, "w_out": w_out, "ret_decay_logit_f": ret_decay_logit_f,
            "ret_decay_logit_b": ret_decay_logit_b, "final_gain": final_gain}


def reference(x, c, norm_gain, w_ada, b_ada, w_in, w_out, ret_decay_logit_f, ret_decay_logit_b, final_gain):
    c_act = jax.nn.silu(c)
    h = x
    for layer in range(DEPTH):
        h = hybrid_layer(h, c_act, norm_gain[layer], w_ada[layer], b_ada[layer], w_in[layer],
                         w_out[layer], ret_decay_logit_f[layer], ret_decay_logit_b[layer])
    return rms_norm(h, final_gain)
```

```cpp
#include <hip/hip_runtime.h>
#include <hip/hip_cooperative_groups.h>
#include <cstdio>
#include <cstdint>
namespace cg = cooperative_groups;
#define ONE_LAUNCH 0
namespace pg8 {
#define PG8_LAS __attribute__((address_space(3)))
typedef unsigned short bf16_t;
typedef short bf16x8 __attribute__((ext_vector_type(8)));
typedef float f32x4 __attribute__((ext_vector_type(4)));
typedef unsigned u32x4 __attribute__((ext_vector_type(4)));
constexpr int BM = 256, BK = 64, HALF = 128, HTB = HALF * BK * 2  , STAGE_BYTES = 8 * HTB, NXCD = 8, WGM = 8;

__host__ __device__ __forceinline__ int lds_byte(int r, int c) { const int st = (r >> 4) * 2 + (c >> 5), rr = r & 15, cc = c & 31, ob = rr * 64 + cc * 2; return st * 1024 + (ob ^ (((ob >> 9) & 1) << 5)); }
__host__ __device__ __forceinline__ void stage_rc(int b, int& R, int& C) { const int st = b / 1024, sb = b % 1024, swz = sb ^ (((sb >> 9) & 1) << 5); R = (st >> 1) * 16 + swz / 64; C = (st & 1) * 32 + (swz % 64) / 2; }
__host__ __device__ __forceinline__ int perm32(int rho) { const int n = rho >> 4, i = rho & 15; return 8 * (i >> 2) + 4 * n + (i & 3); }

struct Unit { int pm, pn; };
struct Gemm { const bf16_t* A; const bf16_t* Bt; int M, N, K; };

struct StaticOrder {
    int nM, nN, nwg, G, c;
    __host__ __device__ void init(int M, int N, int G_, int c_) { nM = M / BM; nN = N / BM; nwg = nM * nN; G = G_; c = c_; }
    __host__ __device__ bool next(int i, Unit& u) const {
        const long L = (long)i * G + c; if (L >= nwg) return false;
        int wgid = (int)L; { const int q = nwg / NXCD, r = nwg % NXCD, xcd = wgid % NXCD, off = wgid / NXCD; wgid = (xcd < r ? xcd * (q + 1) : r * (q + 1) + (xcd - r) * q) + off; }
        const int nig = WGM * nN, gid = wgid / nig, fm = gid * WGM, gsz = (nM - fm) < WGM ? (nM - fm) : WGM;
        u.pm = fm + ((wgid % nig) % gsz); u.pn = (wgid % nig) / gsz; return true;
    }
    __device__ __forceinline__ void a_ready(const Unit&) const {}
    __device__ __forceinline__ void done(const Unit&) const {}
};

__device__ __forceinline__ unsigned cvt_pk_bf16(float lo, float hi) { unsigned r; asm volatile("v_cvt_pk_bf16_f32 %0, %1, %2" : "=v"(r) : "v"(lo), "v"(hi)); return r; }
typedef float f32x2 __attribute__((ext_vector_type(2)));
__device__ __forceinline__ f32x2 gelu_pk(f32x2 v) {
    const f32x2 av = __builtin_elementwise_abs(v), d = av * 0.2316418882f + 1.0f;
    f32x2 t; t.x = __builtin_amdgcn_rcpf(d.x); t.y = __builtin_amdgcn_rcpf(d.y);
    f32x2 q = t * 0.5307027145f + (-0.7265760135f); q = q * t + 0.7107068705f; q = q * t + (-0.142248368f); q = q * t + 0.127414796f; q = q * t;
    const f32x2 s = (v * v) * (-0.72134752044f);
    f32x2 e; e.x = __builtin_amdgcn_exp2f(s.x); e.y = __builtin_amdgcn_exp2f(s.y);
    const f32x2 m = v * (q * e), r = v - m;
    f32x2 o; o.x = v.x < 0.f ? m.x : r.x; o.y = v.y < 0.f ? m.y : r.y; return o;
}

template <int ACT  > struct EpiBf16 {
    static constexpr bool PERM = true, AFTER_DRAIN = false; static_assert(ACT == 0 || ACT == 1, "EpiBf16: ACT is 0 (none) or 1 (gelu_pk)");
    bf16_t* O; int ldc; const float* bias; int split_cols; size_t split_stride; float scale0;
    __device__ __forceinline__ void operator()(const f32x4 (&acc)[2][2][4][2], const Unit& u, int wr, int wc, int fr, int fq) const {
        const int row0 = u.pm * BM + wr * 64 + fr; int colt = u.pn * BM; bf16_t* base = O;
        float sc = 1.f; if (split_cols) { const int t = colt / split_cols; base += (size_t)t * split_stride; colt -= t * split_cols; if (t == 0) sc = scale0; }
        const int col0 = colt + wc * 32 + 8 * fq, bcol0 = u.pn * BM + wc * 32 + 8 * fq;
        f32x4 bv[2][2];
#pragma unroll
        for (int bj = 0; bj < 2; ++bj)
#pragma unroll
            for (int n = 0; n < 2; ++n) bv[bj][n] = bias ? *(const f32x4*)(bias + bcol0 + bj * HALF + 4 * n) : (f32x4){0.f, 0.f, 0.f, 0.f};
#pragma unroll
        for (int ai = 0; ai < 2; ++ai)
#pragma unroll
            for (int m = 0; m < 4; ++m) { bf16_t* rowp = base + (size_t)(row0 + ai * HALF + m * 16) * ldc + col0;
#pragma unroll
                for (int bj = 0; bj < 2; ++bj) { f32x4 v0 = acc[ai][bj][m][0] + bv[bj][0], v1 = acc[ai][bj][m][1] + bv[bj][1];
                    if (ACT == 1) { f32x2 a = gelu_pk((f32x2){v0[0], v0[1]}), b = gelu_pk((f32x2){v0[2], v0[3]}), c = gelu_pk((f32x2){v1[0], v1[1]}), d = gelu_pk((f32x2){v1[2], v1[3]});
                        v0 = (f32x4){a.x, a.y, b.x, b.y}; v1 = (f32x4){c.x, c.y, d.x, d.y}; }
                    v0 = v0 * sc; v1 = v1 * sc; u32x4 w; w.x = cvt_pk_bf16(v0[0], v0[1]); w.y = cvt_pk_bf16(v0[2], v0[3]); w.z = cvt_pk_bf16(v1[0], v1[1]); w.w = cvt_pk_bf16(v1[2], v1[3]);
                    *(u32x4*)(rowp + bj * HALF) = w; } }
    }
};
struct EpiProj {
    static constexpr bool PERM = true, AFTER_DRAIN = false;
    bf16_t* O; int ldc;
    __device__ __forceinline__ void operator()(const f32x4 (&acc)[2][2][4][2], const Unit& u, int wr, int wc, int fr, int fq) const {
        const int row0 = u.pm * BM + wr * 64 + fr; const int col0 = u.pn * BM + wc * 32 + 8 * fq;
        const float sc = (u.pn < 4 || u.pn == 18 || u.pn == 19) ? 0.08838834764831845f : 1.0f;
#pragma unroll
        for (int ai = 0; ai < 2; ++ai)
#pragma unroll
            for (int m = 0; m < 4; ++m) { bf16_t* rowp = O + (size_t)(row0 + ai * HALF + m * 16) * ldc + col0;
#pragma unroll
                for (int bj = 0; bj < 2; ++bj) { f32x4 v0 = acc[ai][bj][m][0] * sc, v1 = acc[ai][bj][m][1] * sc;
                    u32x4 w; w.x = cvt_pk_bf16(v0[0], v0[1]); w.y = cvt_pk_bf16(v0[2], v0[3]); w.z = cvt_pk_bf16(v1[0], v1[1]); w.w = cvt_pk_bf16(v1[2], v1[3]);
                    *(u32x4*)(rowp + bj * HALF) = w; } }
    }
};
struct EpiResid {
    static constexpr bool PERM = false, AFTER_DRAIN = false;
    const float* base; float* out; const float* gate; int ldc, rows_per_batch, gate_stride;
    __device__ __forceinline__ void operator()(const f32x4 (&acc)[2][2][4][2], const Unit& u, int wr, int wc, int fr, int fq) const {
        const int col0 = u.pn * BM + wc * 32 + 4 * fq; const int b = (u.pm * BM) / rows_per_batch;
        f32x4 gv[2][2];
#pragma unroll
        for (int bj = 0; bj < 2; ++bj)
#pragma unroll
            for (int n = 0; n < 2; ++n) gv[bj][n] = *(const f32x4*)(gate + (size_t)b * gate_stride + col0 + bj * HALF + n * 16);
#pragma unroll
        for (int ai = 0; ai < 2; ++ai)
#pragma unroll
            for (int m = 0; m < 4; ++m) { const size_t off = (size_t)(u.pm * BM + ai * HALF + wr * 64 + m * 16 + fr) * ldc + col0;
#pragma unroll
                for (int bj = 0; bj < 2; ++bj)
#pragma unroll
                    for (int n = 0; n < 2; ++n) { const f32x4 bs = *(const f32x4*)(base + off + bj * HALF + n * 16);
                        *(f32x4*)(out + off + bj * HALF + n * 16) = bs + gv[bj][n] * acc[ai][bj][m][n]; } }
    }
};
template <class Epi, class Sched, bool ALIGN_EPI = false, bool SP2 = false>
__device__ __forceinline__ void gemm_phase(PG8_LAS unsigned char* lds, const Gemm g, const Sched& S, const Epi& E) {
    const int tid = threadIdx.x, wid = __builtin_amdgcn_readfirstlane(tid >> 6), lane = tid & 63, wr = wid >> 2, wc = wid & 3, fr = lane & 15, fq = lane >> 4;
    const int K = g.K, nt = K / BK;
    unsigned voffA[2], voffB[2];
#pragma unroll
    for (int i = 0; i < 2; ++i) { int R, C; stage_rc(tid * 16 + i * 8192, R, C); const int Rb = Epi::PERM ? ((R & ~31) + perm32(R & 31)) : R;
        voffA[i] = (unsigned)(R * K + C) * 2u; voffB[i] = (unsigned)(Rb * K + C) * 2u; }
    const size_t kstep = (size_t)(BK * 2);
    const size_t hstep = (size_t)HALF * K * 2;
    const size_t tstep = 2 * hstep;
    const unsigned ldsw = (unsigned)wid * 1024u;
    const int aoff = lds_byte(wr * 64 + fr, fq * 8), boff = lds_byte(wc * 32 + fr, fq * 8);
#define PG8_SA(b, h) (((b) * 2 + (h)) * HTB)
#define PG8_SB(b, h) ((4 + (b) * 2 + (h)) * HTB)
#define PG8_STAGE(bufoff, gbase, voff) do { _Pragma("unroll") for (int _i = 0; _i < 2; ++_i) \
        __builtin_amdgcn_global_load_lds((const unsigned*)((const char*)(gbase) + (voff)[_i]), (PG8_LAS unsigned*)(lds + (bufoff) + ldsw + _i * 8192), 16, 0, 0); } while (0)
#define PG8_LDA(dst, b, h) do { _Pragma("unroll") for (int m = 0; m < 4; ++m) _Pragma("unroll") for (int k = 0; k < 2; ++k) dst[m][k] = *(const PG8_LAS bf16x8*)(lds + PG8_SA(b, h) + aoff + m * 2048 + k * 1024); } while (0)
#define PG8_LDB(dst, b, h) do { _Pragma("unroll") for (int n = 0; n < 2; ++n) _Pragma("unroll") for (int k = 0; k < 2; ++k) dst[n][k] = *(const PG8_LAS bf16x8*)(lds + PG8_SB(b, h) + boff + n * 2048 + k * 1024); } while (0)
#define PG8_MMA(ai, bj, At, Bt) do { __builtin_amdgcn_s_setprio(1); _Pragma("unroll") for (int m = 0; m < 4; ++m) _Pragma("unroll") for (int n = 0; n < 2; ++n) _Pragma("unroll") for (int k = 0; k < 2; ++k) \
        acc[ai][bj][m][n] = __builtin_amdgcn_mfma_f32_16x16x32_bf16(Bt[n][k], At[m][k], acc[ai][bj][m][n], 0, 0, 0); __builtin_amdgcn_s_setprio(0); } while (0)
#define PG8_WAIT_V(n) asm volatile("s_waitcnt vmcnt(" #n ")" ::: "memory")
#define PG8_WAIT_L(n) asm volatile("s_waitcnt lgkmcnt(" #n ")" ::: "memory")
#define PG8_BAR __builtin_amdgcn_s_barrier()
#define PG8_SCHED __builtin_amdgcn_sched_barrier(0)
    Unit cur, nxt; int ui = 0;
    if (!S.next(0, cur)) return;
    f32x4 acc[2][2][4][2];
#pragma unroll
    for (int a = 0; a < 2; ++a)
#pragma unroll
        for (int b = 0; b < 2; ++b)
#pragma unroll
            for (int m = 0; m < 4; ++m)
#pragma unroll
                for (int n = 0; n < 2; ++n) acc[a][b][m][n] = (f32x4){0.f, 0.f, 0.f, 0.f};
    bf16x8 At[4][2], B0[2][2], B1[2][2];
    const char* cA = (const char*)g.A + (size_t)cur.pm * tstep; const char* cB = (const char*)g.Bt + (size_t)cur.pn * tstep;
    S.a_ready(cur);
    if constexpr (SP2) {
        PG8_STAGE(PG8_SB(0, 0), cB, voffB); PG8_STAGE(PG8_SB(0, 1), cB + hstep, voffB); PG8_STAGE(PG8_SA(0, 0), cA, voffA); PG8_STAGE(PG8_SA(0, 1), cA + hstep, voffA);
        if (wr == 1) PG8_BAR;
        PG8_WAIT_V(2); PG8_BAR;
        PG8_STAGE(PG8_SB(1, 0), cB + kstep, voffB); PG8_STAGE(PG8_SA(1, 0), cA + kstep, voffA); PG8_STAGE(PG8_SB(1, 1), cB + hstep + kstep, voffB);
        PG8_WAIT_V(6); PG8_BAR;
    } else {
        PG8_STAGE(PG8_SB(0, 0), cB, voffB); PG8_STAGE(PG8_SA(0, 0), cA, voffA); PG8_STAGE(PG8_SB(0, 1), cB + hstep, voffB); PG8_STAGE(PG8_SA(0, 1), cA + hstep, voffA);
        if (wr == 1) PG8_BAR;
        PG8_WAIT_V(4); PG8_BAR;
        PG8_STAGE(PG8_SB(1, 0), cB + kstep, voffB); PG8_STAGE(PG8_SA(1, 0), cA + kstep, voffA); PG8_STAGE(PG8_SB(1, 1), cB + hstep + kstep, voffB);
        PG8_WAIT_V(6); PG8_BAR;
    }
    for (;;) {
        const bool has_next = S.next(ui + 1, nxt);
        const char* nA = has_next ? (const char*)g.A + (size_t)nxt.pm * tstep : cA; const char* nB = has_next ? (const char*)g.Bt + (size_t)nxt.pn * tstep : cB;
        for (int t = 0; t < nt; t += 2) {
            const bool last = (t == nt - 2);
            const char* a1 = cA + (size_t)(t + 1) * kstep;
            const char* a2 = last ? nA : cA + (size_t)(t + 2) * kstep; const char* b2 = last ? nB : cB + (size_t)(t + 2) * kstep;
            const char* a3 = a2 + kstep; const char* b3 = b2 + kstep;
            if (last && has_next) S.a_ready(nxt);
            if constexpr (SP2) {
            PG8_LDB(B0, 0, 0); PG8_LDB(B1, 0, 1); PG8_SCHED; PG8_LDA(At, 0, 0); PG8_STAGE(PG8_SA(1, 1), a1 + hstep, voffA);
            PG8_WAIT_V(8); PG8_WAIT_L(0); PG8_BAR; PG8_MMA(0, 0, At, B0); PG8_MMA(0, 1, At, B1); PG8_BAR; PG8_SCHED;
            PG8_LDA(At, 0, 1); PG8_STAGE(PG8_SB(0, 0), b2, voffB); PG8_STAGE(PG8_SB(0, 1), b2 + hstep, voffB); PG8_STAGE(PG8_SA(0, 0), a2, voffA);
            PG8_WAIT_V(8); PG8_WAIT_L(0); PG8_BAR; PG8_MMA(1, 0, At, B0); PG8_MMA(1, 1, At, B1); PG8_BAR; PG8_SCHED;
            PG8_LDB(B0, 1, 0); PG8_LDB(B1, 1, 1); PG8_SCHED; PG8_LDA(At, 1, 0); PG8_STAGE(PG8_SA(0, 1), a2 + hstep, voffA);
            PG8_WAIT_V(8); PG8_WAIT_L(0); PG8_BAR; PG8_MMA(0, 0, At, B0); PG8_MMA(0, 1, At, B1); PG8_BAR; PG8_SCHED;
            PG8_LDA(At, 1, 1); PG8_STAGE(PG8_SB(1, 0), b3, voffB); PG8_STAGE(PG8_SB(1, 1), b3 + hstep, voffB); PG8_STAGE(PG8_SA(1, 0), a3, voffA);
            PG8_WAIT_V(8); PG8_WAIT_L(0); PG8_BAR; PG8_MMA(1, 0, At, B0); PG8_MMA(1, 1, At, B1); PG8_BAR; PG8_SCHED;
            } else {
            PG8_LDB(B0, 0, 0); PG8_SCHED; PG8_LDA(At, 0, 0); PG8_STAGE(PG8_SA(1, 1), a1 + hstep, voffA);
            PG8_WAIT_L(8); PG8_BAR; PG8_WAIT_L(0); PG8_MMA(0, 0, At, B0); PG8_BAR; PG8_SCHED;
            PG8_LDB(B1, 0, 1); PG8_STAGE(PG8_SB(0, 0), b2, voffB);
            PG8_BAR; PG8_WAIT_L(0); PG8_MMA(0, 1, At, B1); PG8_BAR;
            PG8_LDA(At, 0, 1); PG8_STAGE(PG8_SA(0, 0), a2, voffA);
            PG8_BAR; PG8_WAIT_L(0); PG8_MMA(1, 0, At, B0); PG8_BAR; PG8_SCHED;
            PG8_STAGE(PG8_SB(0, 1), b2 + hstep, voffB);
            PG8_WAIT_V(6); PG8_BAR; PG8_MMA(1, 1, At, B1); PG8_BAR;
            PG8_LDB(B0, 1, 0); PG8_SCHED; PG8_LDA(At, 1, 0); PG8_STAGE(PG8_SA(0, 1), a2 + hstep, voffA);
            PG8_WAIT_L(8); PG8_BAR; PG8_WAIT_L(0); PG8_MMA(0, 0, At, B0); PG8_BAR; PG8_SCHED;
            PG8_LDB(B1, 1, 1); PG8_STAGE(PG8_SB(1, 0), b3, voffB);
            PG8_BAR; PG8_WAIT_L(0); PG8_MMA(0, 1, At, B1); PG8_BAR;
            PG8_LDA(At, 1, 1); PG8_STAGE(PG8_SA(1, 0), a3, voffA);
            PG8_BAR; PG8_WAIT_L(0); PG8_MMA(1, 0, At, B0); PG8_BAR; PG8_SCHED;
            PG8_STAGE(PG8_SB(1, 1), b3 + hstep, voffB);
            PG8_WAIT_V(6); PG8_BAR; PG8_MMA(1, 1, At, B1); PG8_BAR;
            }
        }
        if constexpr (ALIGN_EPI) { if (wr == 0) PG8_BAR; }
        if constexpr (!Epi::AFTER_DRAIN) { E(acc, cur, wr, wc, fr, fq); S.done(cur); }
        if (!has_next) break;
#pragma unroll
        for (int a = 0; a < 2; ++a)
#pragma unroll
            for (int b = 0; b < 2; ++b)
#pragma unroll
                for (int m = 0; m < 4; ++m)
#pragma unroll
                    for (int n = 0; n < 2; ++n) acc[a][b][m][n] = (f32x4){0.f, 0.f, 0.f, 0.f};
        cur = nxt; cA = nA; cB = nB; ++ui;
        if constexpr (ALIGN_EPI) { if (wr == 1) PG8_BAR; }
    }
    PG8_WAIT_V(0);
    if constexpr (!ALIGN_EPI) { if (wr == 0) PG8_BAR; }
    PG8_BAR;
    if constexpr (Epi::AFTER_DRAIN) { E.fused(acc, cur, wr, wc, fr, fq, lds, wid, lane); S.done(cur); }
#undef PG8_SA
#undef PG8_SB
#undef PG8_STAGE
#undef PG8_LDA
#undef PG8_LDB
#undef PG8_MMA
#undef PG8_WAIT_V
#undef PG8_WAIT_L
#undef PG8_BAR
#undef PG8_SCHED
}
}
#define GAS __attribute__((address_space(1)))
#define LAS __attribute__((address_space(3)))
typedef unsigned short bf16;
typedef unsigned v4u __attribute__((ext_vector_type(4)));
typedef float f32x4 __attribute__((ext_vector_type(4)));
typedef short bf16x8 __attribute__((ext_vector_type(8)));
typedef GAS unsigned gu32;
typedef GAS unsigned long long gu64;
#define RLX_AGENT __ATOMIC_RELAXED, __HIP_MEMORY_SCOPE_AGENT
#define LDS_WAIT() asm volatile("s_waitcnt lgkmcnt(0)" ::: "memory")
#define VM_WAIT() asm volatile("s_waitcnt vmcnt(0)" ::: "memory")
__device__ __forceinline__ unsigned long long rt() { return __builtin_amdgcn_s_memrealtime(); }
__device__ __forceinline__ unsigned f2bf(float f) { unsigned u = __builtin_bit_cast(unsigned, f); return (u + 0x7fffu + ((u >> 16) & 1u)) >> 16; }
__device__ __forceinline__ unsigned pk2(float lo, float hi) { return f2bf(lo) | (f2bf(hi) << 16); }

#define XB_TMO      128
#define XB_XCNT(j)  (256  + 64 * (j))
#define XB_XSUB(j)  (1280 + 64 * (j))
#define XB_XGEN(j)  (2304 + 64 * (j))
#define XB_TOP      3328
#define XB_TOPGEN   3392
#define XCD_BAR_WORDS 3456
#define XB_SPIN_CAP (1u << 18)

__device__ __forceinline__ unsigned xb_ld(unsigned* p)              { return __hip_atomic_load(p, __ATOMIC_RELAXED, __HIP_MEMORY_SCOPE_AGENT); }
__device__ __forceinline__ unsigned xb_add(unsigned* p, unsigned v) { return __hip_atomic_fetch_add(p, v, __ATOMIC_RELAXED, __HIP_MEMORY_SCOPE_AGENT); }
__device__ __forceinline__ unsigned xb_xcc_id() { return (unsigned)__builtin_amdgcn_s_getreg((3 << 11) | 20) & 0xFu; }
#define XB_SPIN(cond, bar) do { unsigned _sp = 0; while (cond) { __builtin_amdgcn_s_sleep(1); \
    if ((++_sp & 255u) == 0u) { if (xb_ld(&(bar)[XB_TMO])) break; if (_sp > XB_SPIN_CAP) { atomicAdd(&(bar)[XB_TMO], 1u); break; } } } } while (0)

struct XcdBarrier {
    unsigned* bar; unsigned x;
    volatile LAS unsigned* st;
};

__device__ __forceinline__ XcdBarrier xcd_barrier_post(unsigned* bar, volatile LAS unsigned* st) {
    XcdBarrier b; b.bar = bar; b.x = xb_xcc_id(); b.st = st;
    if (threadIdx.x == 0) (void)xb_add(&bar[XB_XCNT(b.x)], 1u);
    return b;
}
__device__ __forceinline__ void xcd_barrier_complete(unsigned* bar, unsigned x, unsigned& nloc, unsigned& nx) {
    const unsigned G = gridDim.x * gridDim.y * gridDim.z;
    unsigned sum, cnt, mine, sp = 0u;
    for (;;) {
        sum = 0u; cnt = 0u; mine = 0u;
#pragma unroll
        for (unsigned j = 0; j < 16; ++j) { const unsigned c = xb_ld(&bar[XB_XCNT(j)]); sum += c; cnt += (c > 0u) ? 1u : 0u; mine = (j == x) ? c : mine; }
        if (sum == G) break;
        __builtin_amdgcn_s_sleep(1);
        if ((++sp & 255u) == 0u) { if (xb_ld(&bar[XB_TMO])) break; if (sp > XB_SPIN_CAP) { atomicAdd(&bar[XB_TMO], 1u); break; } }
    }
    nloc = mine > 0u ? mine : 1u; nx = cnt > 0u ? cnt : 1u;
}

__device__ __forceinline__ void xcd_barrier(const XcdBarrier& b) {
    asm volatile("s_waitcnt vmcnt(0)" ::: "memory");
    __syncthreads();
    if (threadIdx.x == 0) {
        unsigned* bar = b.bar;
        __builtin_amdgcn_s_waitcnt(0);
        unsigned nloc = b.st[0], nx = b.st[1];
        if (nloc == 0u) { xcd_barrier_complete(bar, b.x, nloc, nx); b.st[0] = nloc; b.st[1] = nx; }
        const unsigned old = xb_add(&bar[XB_XSUB(b.x)], 1u);
        const unsigned gen = old / nloc;
        if (old + 1u == (gen + 1u) * nloc) {
            __builtin_amdgcn_fence(__ATOMIC_RELEASE, "agent");
            asm volatile("s_waitcnt vmcnt(0)" ::: "memory");
            const unsigned og = xb_add(&bar[XB_TOP], 1u);
            const unsigned tg = og / nx;
            if (og + 1u == (tg + 1u) * nx) xb_add(&bar[XB_TOPGEN], 1u);
            else XB_SPIN(xb_ld(&bar[XB_TOPGEN]) == tg, bar);
            __builtin_amdgcn_fence(__ATOMIC_ACQUIRE, "agent");
            xb_add(&bar[XB_XGEN(b.x)], 1u);
            asm volatile("s_waitcnt vmcnt(0)" ::: "memory");
        } else {
            XB_SPIN(xb_ld(&bar[XB_XGEN(b.x)]) == gen, bar);
            __builtin_amdgcn_fence(__ATOMIC_ACQUIRE, "agent");
            asm volatile("s_waitcnt vmcnt(0)" ::: "memory");
        }
    }
    __syncthreads();
}
constexpr int NWAVES = 8;
constexpr int NB = 2, SEQ = 4096, M = NB * SEQ, D = 2048, NP = 7168, DEPTH = 4, MODW = 3 * D;
constexpr int C_QA = 0, C_KA = 1024, C_VA = 2048, C_ZA = 3072, C_QR = 4096, C_KR = 4608, C_VR = 5120, C_ZR = 6144;
constexpr float EPS = 1e-6f;
#ifndef ONE_LAUNCH
#define ONE_LAUNCH 1
#endif
#ifndef NAIVE_ATT
#define NAIVE_ATT 1
#endif
#ifndef NAIVE_RET
#define NAIVE_RET 1
#endif
constexpr size_t MiB = 1u << 20;
constexpr size_t WS_CTL = 0, CTL_ZERO_BYTES = 64 * 1024;
constexpr size_t WS_MOD = 1 * MiB;
constexpr size_t WS_WIN = 2 * MiB;
constexpr size_t WS_WOUT = 114 * MiB;
constexpr size_t WS_HN = 146 * MiB;
constexpr size_t WS_PROJ = 178 * MiB;
constexpr size_t WS_Y = 290 * MiB;
constexpr size_t WS_X = 322 * MiB;
constexpr size_t WS_RET = 386 * MiB;
constexpr size_t WS_END = 482 * MiB;
constexpr int CW_BAR = 1024;
static_assert((CW_BAR + XCD_BAR_WORDS) * 4 <= (int)CTL_ZERO_BYTES, "CTL");
constexpr int RING_BYTES = 131072, MISC_OFF = RING_BYTES + 320, LDS_BYTES = 147456;

__device__ __forceinline__ float bf2f(unsigned u) { return __uint_as_float(u << 16); }
__device__ __forceinline__ float silu_f(float v) { return v / (1.0f + __expf(-v)); }
__device__ __forceinline__ float wave_sum(float v) {
#pragma unroll
    for (int o = 1; o < 64; o <<= 1) v += __shfl_xor(v, o);
    return v;
}
__device__ __forceinline__ float wave_max(float v) {
#pragma unroll
    for (int o = 1; o < 64; o <<= 1) v = fmaxf(v, __shfl_xor(v, o));
    return v;
}

__device__ __forceinline__ void p0_gemv(const float* c, const float* w_ada, const float* b_ada, float* MOD, LAS unsigned char* lds, int g, int tid) {
    const int wave = tid >> 6, lane = tid & 63, rs = lane >> 3, cgp = lane & 7;
    const int l = g >> 6, col0 = (g & 63) * 96;
    const float* W = w_ada + (size_t)l * D * MODW + col0 + cgp * 12;
    float a0[12], a1[12];
#pragma unroll
    for (int j = 0; j < 12; ++j) { a0[j] = 0.f; a1[j] = 0.f; }
#pragma unroll 4
    for (int it = 0; it < 32; ++it) {
        const int k = wave * 256 + it * 8 + rs;
        const float s0 = silu_f(c[k]), s1 = silu_f(c[D + k]);
        const f32x4* wp = (const f32x4*)(W + (size_t)k * MODW);
        const f32x4 w0 = wp[0], w1 = wp[1], w2 = wp[2];
#pragma unroll
        for (int j = 0; j < 4; ++j) { a0[j] += s0 * w0[j]; a0[4 + j] += s0 * w1[j]; a0[8 + j] += s0 * w2[j]; a1[j] += s1 * w0[j]; a1[4 + j] += s1 * w1[j]; a1[8 + j] += s1 * w2[j]; }
    }
#pragma unroll
    for (int j = 0; j < 12; ++j) {
        a0[j] += __shfl_xor(a0[j], 8); a0[j] += __shfl_xor(a0[j], 16); a0[j] += __shfl_xor(a0[j], 32);
        a1[j] += __shfl_xor(a1[j], 8); a1[j] += __shfl_xor(a1[j], 16); a1[j] += __shfl_xor(a1[j], 32);
    }
    LAS float* red = (LAS float*)lds;
    if (rs == 0) {
#pragma unroll
        for (int j = 0; j < 12; ++j) { red[(wave * 2 + 0) * 96 + cgp * 12 + j] = a0[j]; red[(wave * 2 + 1) * 96 + cgp * 12 + j] = a1[j]; }
    }
    __syncthreads();
    if (tid < 192) { const int b = tid / 96, j = tid % 96; float s = b_ada[l * MODW + col0 + j];
#pragma unroll
        for (int w = 0; w < 8; ++w) s += red[(w * 2 + b) * 96 + j];
        MOD[(size_t)(l * 2 + b) * MODW + col0 + j] = s; }
    __syncthreads();
}
__device__ __forceinline__ void p0_transpose_item(const float* W, int K, int N, bf16* WT, LAS float* scr, int item, int lane) {
    const int nblk = N / 32, kb = item / nblk, nb = item % nblk, k0 = 64 * kb, n0 = 32 * nb;
#pragma unroll 8
    for (int i = 0; i < 32; ++i) { const int kk = 2 * i + (lane >> 5); scr[kk * 33 + (lane & 31)] = W[(size_t)(k0 + kk) * N + n0 + (lane & 31)]; }
    LDS_WAIT(); asm volatile("" ::: "memory");
    const int c = lane & 7;
#pragma unroll
    for (int j = 0; j < 4; ++j) { const int n = (lane >> 3) + 8 * j; const LAS float* s = scr + (8 * c) * 33 + n;
        v4u o; o.x = pk2(s[0 * 33], s[1 * 33]); o.y = pk2(s[2 * 33], s[3 * 33]); o.z = pk2(s[4 * 33], s[5 * 33]); o.w = pk2(s[6 * 33], s[7 * 33]);
        *(GAS v4u*)(WT + (size_t)(n0 + n) * K + k0 + 8 * c) = o; }
    LDS_WAIT(); asm volatile("" ::: "memory");
}
__device__ __forceinline__ void p0_transposes(const float* w_in, const float* w_out, bf16* WIN_T, bf16* WOUT_T, LAS unsigned char* lds, int gw, int NGW, int wave, int lane) {
    LAS float* scr = (LAS float*)(lds + wave * 16384);
    constexpr int I_IN = (D / 64) * (NP / 32), I_OUT = (D / 64) * (D / 32), I_L = I_IN + I_OUT;
    for (int it = gw; it < DEPTH * I_L; it += NGW) {
        const int l = it / I_L; int r = it % I_L;
        if (r < I_IN) p0_transpose_item(w_in + (size_t)l * D * NP, D, NP, WIN_T + (size_t)l * NP * D, scr, r, lane);
        else p0_transpose_item(w_out + (size_t)l * D * D, D, D, WOUT_T + (size_t)l * D * D, scr, r - I_IN, lane);
    }
}

template <bool FINAL>
__device__ __forceinline__ void norm_rows(const float* src, const float* gain, const float* mod, bf16* outb, float* outf, int gw, int NGW, int lane) {
    for (int m = gw; m < M; m += NGW) {
        const f32x4* xr = (const f32x4*)(src + (size_t)m * D) + lane;
        f32x4 v[8]; float ss = 0.f;
#pragma unroll
        for (int j = 0; j < 8; ++j) { v[j] = xr[64 * j]; ss += (v[j].x * v[j].x + v[j].y * v[j].y) + (v[j].z * v[j].z + v[j].w * v[j].w); }
        const float rstd = rsqrtf(wave_sum(ss) * (1.0f / D) + EPS);
        const int b = m / SEQ;
#pragma unroll
        for (int j = 0; j < 8; ++j) {
            const int col = 4 * (lane + 64 * j);
            const f32x4 g4 = *(const f32x4*)(gain + col);
            f32x4 y = v[j] * rstd * g4;
            if constexpr (FINAL) { *(f32x4*)(outf + (size_t)m * D + col) = y; }
            else {
                const f32x4 sh = *(const f32x4*)(mod + (size_t)b * MODW + col), sc = *(const f32x4*)(mod + (size_t)b * MODW + D + col);
                y = y * (sc + 1.0f) + sh;
                *(unsigned long long*)(outb + (size_t)m * D + col) = (unsigned long long)pk2(y.x, y.y) | ((unsigned long long)pk2(y.z, y.w) << 32);
            }
        }
    }
}

__device__ __forceinline__ void attn_naive(const bf16* PROJ, bf16* Y, LAS unsigned char* lds, int gw, int NGW, int wave, int lane) {
    LAS float* qs = (LAS float*)(lds + wave * 4096);
    LAS float* ps = qs + 128;
    for (int item = gw; item < M * 8; item += NGW) {
        const int m = item >> 3, h = item & 7, b = m / SEQ, t = m % SEQ;
        const float slope = exp2f(-(float)(h + 1));
        { const unsigned qq = *(const unsigned*)(PROJ + (size_t)m * NP + C_QA + h * 128 + 2 * lane); qs[2 * lane] = bf2f(qq & 0xffffu); qs[2 * lane + 1] = bf2f(qq >> 16); }
        LDS_WAIT(); asm volatile("" ::: "memory");
        float sc[7]; float mx = -1e30f;
#pragma unroll
        for (int r = 0; r < 7; ++r) {
            const int i = lane + 64 * r; const int p = i / 129, j = i % 129 - 64; const int dil = (p == 0) ? 1 : ((p == 1) ? 4 : 16);
            const int off = j * dil, s = t + off; const bool valid = (i < 387) && (s >= 0) && (s < SEQ);
            float dot = 0.f;
            if (valid) {
                const bf16* kr = PROJ + (size_t)(b * SEQ + s) * NP + C_KA + h * 128;
#pragma unroll 4
                for (int c8 = 0; c8 < 16; ++c8) { const v4u kk = *(const v4u*)(kr + 8 * c8); const f32x4 q0 = *(const LAS f32x4*)(qs + 8 * c8), q1 = *(const LAS f32x4*)(qs + 8 * c8 + 4);
                    dot += q0.x * bf2f(kk.x & 0xffffu) + q0.y * bf2f(kk.x >> 16) + q0.z * bf2f(kk.y & 0xffffu) + q0.w * bf2f(kk.y >> 16)
                         + q1.x * bf2f(kk.z & 0xffffu) + q1.y * bf2f(kk.z >> 16) + q1.z * bf2f(kk.w & 0xffffu) + q1.w * bf2f(kk.w >> 16); }
            }
            sc[r] = valid ? dot - slope * fabsf((float)off) : -1e30f;
            mx = fmaxf(mx, sc[r]);
        }
        mx = wave_max(mx);
        float lsum = 0.f;
#pragma unroll
        for (int r = 0; r < 7; ++r) { const float pr = __expf(sc[r] - mx); lsum += pr; ps[lane + 64 * r] = pr; }
        lsum = wave_sum(lsum);
        LDS_WAIT(); asm volatile("" ::: "memory");
        float o0 = 0.f, o1 = 0.f;
        for (int p = 0; p < 3; ++p) { const int dil = (p == 0) ? 1 : ((p == 1) ? 4 : 16);
#pragma unroll 8
            for (int jj = 0; jj < 129; ++jj) { int s = t + (jj - 64) * dil; s = s < 0 ? 0 : (s >= SEQ ? SEQ - 1 : s);
                const float pv = ps[p * 129 + jj];
                const unsigned vv = *(const unsigned*)(PROJ + (size_t)(b * SEQ + s) * NP + C_VA + h * 128 + 2 * lane);
                o0 += pv * bf2f(vv & 0xffffu); o1 += pv * bf2f(vv >> 16); } }
        const unsigned zz = *(const unsigned*)(PROJ + (size_t)m * NP + C_ZA + h * 128 + 2 * lane);
        const float inv = 1.0f / lsum;
        *(unsigned*)(Y + (size_t)m * D + h * 128 + 2 * lane) = pk2(o0 * inv * silu_f(bf2f(zz & 0xffffu)), o1 * inv * silu_f(bf2f(zz >> 16)));
        LDS_WAIT(); asm volatile("" ::: "memory");
    }
}

__device__ __forceinline__ void ret_naive_scan(const bf16* PROJ, const float* dec_f, const float* dec_b, float* OUT, LAS unsigned char* lds, int unit, int tid) {
    const int dir = unit >> 3, b = (unit >> 2) & 1, h = unit & 3;
    const float logit = dir ? dec_b[h] : dec_f[h]; const float gamma = 1.0f / (1.0f + __expf(-logit));
    const int e = tid & 255, half = tid >> 8;
    LAS float* qk = (LAS float*)lds;
    LAS float* red = qk + 512;
    float S[64];
#pragma unroll
    for (int d = 0; d < 64; ++d) S[d] = 0.f;
    const int qkcol = (tid < 128) ? (C_QR + h * 128 + tid) : (C_KR + h * 128 + (tid & 127));
    int t0 = dir ? SEQ - 1 : 0;
    unsigned short nqk = PROJ[(size_t)(b * SEQ + t0) * NP + qkcol], nv = PROJ[(size_t)(b * SEQ + t0) * NP + C_VR + h * 256 + e];
    for (int step = 0; step < SEQ; ++step) {
        const int t = dir ? SEQ - 1 - step : step, m = b * SEQ + t, buf = step & 1;
        if (tid < 256) qk[buf * 256 + tid] = bf2f(nqk);
        const float ve = bf2f(nv);
        if (step + 1 < SEQ) { const int tn = dir ? t - 1 : t + 1; nqk = PROJ[(size_t)(b * SEQ + tn) * NP + qkcol]; nv = PROJ[(size_t)(b * SEQ + tn) * NP + C_VR + h * 256 + e]; }
        __syncthreads();
        float part = 0.f;
        const LAS float* qp = qk + buf * 256 + 64 * half; const LAS float* kp = qp + 128;
#pragma unroll
        for (int d = 0; d < 64; ++d) { S[d] = gamma * S[d] + kp[d] * ve; part += qp[d] * S[d]; }
        if (half == 1) red[buf * 256 + e] = part;
        __syncthreads();
        if (half == 0) OUT[((size_t)dir * M + m) * 1024 + h * 256 + e] = part + red[buf * 256 + e];
    }
}
__device__ __forceinline__ void ret_naive_combine(const float* OUT, const bf16* PROJ, bf16* Y, int gw, int NGW, int lane) {
    for (int item = gw; item < M * 4; item += NGW) {
        const int m = item >> 2, h = item & 3;
        const f32x4 a = *(const f32x4*)(OUT + (size_t)m * 1024 + h * 256 + 4 * lane), bq = *(const f32x4*)(OUT + ((size_t)M + m) * 1024 + h * 256 + 4 * lane);
        const f32x4 o = a + bq;
        const float r = rsqrtf(wave_sum((o.x * o.x + o.y * o.y) + (o.z * o.z + o.w * o.w)) * (1.0f / 256.0f) + EPS);
        const unsigned long long zz = *(const unsigned long long*)(PROJ + (size_t)m * NP + C_ZR + h * 256 + 4 * lane);
        const unsigned z0 = (unsigned)zz, z1 = (unsigned)(zz >> 32);
        const float y0 = o.x * r * silu_f(bf2f(z0 & 0xffffu)), y1 = o.y * r * silu_f(bf2f(z0 >> 16)), y2 = o.z * r * silu_f(bf2f(z1 & 0xffffu)), y3 = o.w * r * silu_f(bf2f(z1 >> 16));
        *(unsigned long long*)(Y + (size_t)m * D + 1024 + h * 256 + 4 * lane) = (unsigned long long)pk2(y0, y1) | ((unsigned long long)pk2(y2, y3) << 32);
    }
}

struct Args { const float* in[10]; float* out; unsigned char* ws; int ph_lo, ph_hi, use_bar, pad; };
constexpr int N_PHASES = 2 + 5 * DEPTH;

__device__ __forceinline__ unsigned char* ld_ptr(volatile LAS unsigned* tab, int i) {
    unsigned lo = tab[2 * i], hi = tab[2 * i + 1];
    lo = __builtin_amdgcn_readfirstlane(lo); hi = __builtin_amdgcn_readfirstlane(hi);
    return (unsigned char*)(((unsigned long long)hi << 32) | lo);
}
__global__ void __launch_bounds__(NWAVES * 64, 2) fwd_kernel(Args args) {
    extern __shared__ __attribute__((aligned(16))) unsigned char lds_raw[];
    LAS unsigned char* lds = (LAS unsigned char*)lds_raw;
    const int tid = threadIdx.x;
    volatile LAS unsigned* MISC = (volatile LAS unsigned*)(lds + MISC_OFF);
    volatile LAS unsigned* TAB = MISC + 32;
    for (int u = tid; u < (LDS_BYTES - RING_BYTES) / 4; u += NWAVES * 64) ((LAS unsigned*)(lds + RING_BYTES))[u] = 0u;
    __syncthreads();
    if (tid < 12) { const unsigned long long v = (tid < 10) ? (unsigned long long)args.in[tid] : (tid == 10 ? (unsigned long long)args.out : (unsigned long long)args.ws);
        TAB[2 * tid] = (unsigned)v; TAB[2 * tid + 1] = (unsigned)(v >> 32); }
    __syncthreads();
    if (tid == 0) { MISC[11] = (unsigned)args.ph_lo; MISC[12] = (unsigned)args.ph_hi; MISC[13] = (unsigned)args.use_bar; }
    if (args.use_bar) { const XcdBarrier b0 = xcd_barrier_post((unsigned*)(args.ws + WS_CTL) + CW_BAR, MISC + 8); if (tid == 0) MISC[10] = b0.x; }
    __syncthreads();
#define CFG(i) ((int)__builtin_amdgcn_readfirstlane(MISC[(i)]))
#define IN(k) (CFG(11) <= (k) && (k) < CFG(12))
#define GRID_BAR() do { if (CFG(13)) { XcdBarrier b_; b_.bar = (unsigned*)(ld_ptr(TAB, 11) + WS_CTL) + CW_BAR; b_.x = (unsigned)CFG(10); b_.st = MISC + 8; xcd_barrier(b_); } } while (0)
#define PTR(i) ld_ptr(TAB, (i))
#define WAVE_IDS() int t__ = threadIdx.x; asm volatile("" : "+v"(t__)); const int lane = t__ & 63, wave = __builtin_amdgcn_readfirstlane(t__ >> 6), gw = blockIdx.x * NWAVES + wave, NGW = gridDim.x * NWAVES

    if (IN(0)) {
        WAVE_IDS(); unsigned char* ws = PTR(11);
        p0_gemv((const float*)PTR(1), (const float*)PTR(3), (const float*)PTR(4), (float*)(ws + WS_MOD), lds, blockIdx.x, t__);
        p0_transposes((const float*)PTR(5), (const float*)PTR(6), (bf16*)(ws + WS_WIN), (bf16*)(ws + WS_WOUT), lds, gw, NGW, wave, lane);
        __syncthreads();
        if (CFG(13)) cg::this_grid().sync();
        GRID_BAR();
    }
    for (int l = 0; l < DEPTH; ++l) {
        const int pb = 1 + 5 * l;
        if (IN(pb + 0)) { WAVE_IDS(); unsigned char* ws = PTR(11);
            norm_rows<false>((l == 0) ? (const float*)PTR(0) : (const float*)(ws + WS_X), (const float*)PTR(2) + l * D, (const float*)(ws + WS_MOD) + (size_t)l * 2 * MODW, (bf16*)(ws + WS_HN), nullptr, gw, NGW, lane);
            GRID_BAR(); }
        if (IN(pb + 1)) { unsigned char* ws = PTR(11);
            pg8::Gemm g{(const bf16*)(ws + WS_HN), (const bf16*)(ws + WS_WIN) + (size_t)l * NP * D, M, NP, D}; pg8::StaticOrder S; S.init(M, NP, gridDim.x, blockIdx.x);
            pg8::EpiProj E{(bf16*)(ws + WS_PROJ), NP};
            pg8::gemm_phase<pg8::EpiProj, pg8::StaticOrder, true, true>(lds, g, S, E);
            GRID_BAR();
        }
        if (IN(pb + 2)) { WAVE_IDS(); unsigned char* ws = PTR(11);
#if NAIVE_RET
            if (blockIdx.x < 16) ret_naive_scan((const bf16*)(ws + WS_PROJ), (const float*)PTR(7) + l * 4, (const float*)PTR(8) + l * 4, (float*)(ws + WS_RET), lds, blockIdx.x, t__);
            __syncthreads();
#endif
#if NAIVE_ATT
            attn_naive((const bf16*)(ws + WS_PROJ), (bf16*)(ws + WS_Y), lds, gw, NGW, wave, lane);
#endif
            GRID_BAR();
        }
        if (IN(pb + 3)) { WAVE_IDS(); unsigned char* ws = PTR(11);
#if NAIVE_RET
            ret_naive_combine((const float*)(ws + WS_RET), (const bf16*)(ws + WS_PROJ), (bf16*)(ws + WS_Y), gw, NGW, lane);
#endif
            GRID_BAR();
        }
        if (IN(pb + 4)) { unsigned char* ws = PTR(11);
            pg8::Gemm g{(const bf16*)(ws + WS_Y), (const bf16*)(ws + WS_WOUT) + (size_t)l * D * D, M, D, D}; pg8::StaticOrder S; S.init(M, D, gridDim.x, blockIdx.x);
            pg8::EpiResid E{(l == 0) ? (const float*)PTR(0) : (const float*)(ws + WS_X), (float*)(ws + WS_X), (const float*)(ws + WS_MOD) + (size_t)l * 2 * MODW + 2 * D, D, SEQ, MODW};
            pg8::gemm_phase<pg8::EpiResid, pg8::StaticOrder, true, true>(lds, g, S, E);
            GRID_BAR();
        }
    }
    if (IN(N_PHASES - 1)) { WAVE_IDS(); unsigned char* ws = PTR(11);
        norm_rows<true>((const float*)(ws + WS_X), (const float*)PTR(9), nullptr, nullptr, (float*)PTR(10), gw, NGW, lane); }
#undef IN
#undef GRID_BAR
}

extern "C" void kernel_launch(void* const* d_in, const int* in_sizes, int n_in, void* d_out, int out_size, void* d_ws, size_t ws_size, hipStream_t stream) {
    static int grid = 0;
    if (grid == 0) {
        if (n_in != 10 || out_size != M * D || ws_size < WS_END) { fprintf(stderr, "kernel_launch: unexpected shapes (n_in %d out %d ws %zu)\n", n_in, out_size, ws_size); grid = -1; return; }
        int dev = 0, cus = 0, per_cu = 0;
        hipGetDevice(&dev); hipDeviceGetAttribute(&cus, hipDeviceAttributeMultiprocessorCount, dev);
        if (hipFuncSetAttribute((const void*)fwd_kernel, hipFuncAttributeMaxDynamicSharedMemorySize, LDS_BYTES) != hipSuccess) { fprintf(stderr, "kernel_launch: hipFuncSetAttribute failed\n"); grid = -1; return; }
        if (hipOccupancyMaxActiveBlocksPerMultiprocessor(&per_cu, (const void*)fwd_kernel, NWAVES * 64, LDS_BYTES) != hipSuccess || per_cu < 1) { fprintf(stderr, "kernel_launch: occupancy query says %d\n", per_cu); per_cu = 1; }
        (void)hipGetLastError();
        grid = cus * 1;
        fprintf(stderr, "kernel_launch: grid %d (cus %d, per_cu %d)\n", grid, cus, per_cu);
    }
    if (grid < 0) return;
    Args a{};
    for (int i = 0; i < 10; ++i) a.in[i] = (const float*)d_in[i];
    a.out = (float*)d_out; a.ws = (unsigned char*)d_ws;
#if ONE_LAUNCH
    if (hipMemsetAsync((char*)d_ws + WS_CTL, 0, CTL_ZERO_BYTES, stream) != hipSuccess) { fprintf(stderr, "kernel_launch: memset failed\n"); return; }
    a.ph_lo = 0; a.ph_hi = N_PHASES; a.use_bar = 1;
    void* kargs[] = {&a};
    hipError_t e = hipLaunchCooperativeKernel((const void*)fwd_kernel, dim3(grid), dim3(NWAVES * 64), kargs, LDS_BYTES, stream);
    if (e != hipSuccess) fprintf(stderr, "kernel_launch: cooperative launch failed: %s (grid %d)\n", hipGetErrorString(e), grid);
#else
    for (int ph = 0; ph < N_PHASES; ++ph) {
        a.ph_lo = ph; a.ph_hi = ph + 1; a.use_bar = 0;
        hipLaunchKernelGGL(fwd_kernel, dim3(grid), dim3(NWAVES * 64), LDS_BYTES, stream, a);
    }
#endif
}
```

```cpp
#include <hip/hip_runtime.h>
#include <hip/hip_cooperative_groups.h>
#include <cstdio>
#include <cstdint>
namespace cg = cooperative_groups;
#define ONE_LAUNCH 1
namespace pg8 {
#define PG8_LAS __attribute__((address_space(3)))
typedef unsigned short bf16_t;
typedef short bf16x8 __attribute__((ext_vector_type(8)));
typedef float f32x4 __attribute__((ext_vector_type(4)));
typedef unsigned u32x4 __attribute__((ext_vector_type(4)));
constexpr int BM = 256, BK = 64, HALF = 128, HTB = HALF * BK * 2  , STAGE_BYTES = 8 * HTB, NXCD = 8, WGM = 8;

__host__ __device__ __forceinline__ int lds_byte(int r, int c) { const int st = (r >> 4) * 2 + (c >> 5), rr = r & 15, cc = c & 31, ob = rr * 64 + cc * 2; return st * 1024 + (ob ^ (((ob >> 9) & 1) << 5)); }
__host__ __device__ __forceinline__ void stage_rc(int b, int& R, int& C) { const int st = b / 1024, sb = b % 1024, swz = sb ^ (((sb >> 9) & 1) << 5); R = (st >> 1) * 16 + swz / 64; C = (st & 1) * 32 + (swz % 64) / 2; }
__host__ __device__ __forceinline__ int perm32(int rho) { const int n = rho >> 4, i = rho & 15; return 8 * (i >> 2) + 4 * n + (i & 3); }

struct Unit { int pm, pn; };
struct Gemm { const bf16_t* A; const bf16_t* Bt; int M, N, K; };

struct StaticOrder {
    int nM, nN, nwg, G, c;
    __host__ __device__ void init(int M, int N, int G_, int c_) { nM = M / BM; nN = N / BM; nwg = nM * nN; G = G_; c = c_; }
    __host__ __device__ bool next(int i, Unit& u) const {
        const long L = (long)i * G + c; if (L >= nwg) return false;
        int wgid = (int)L; { const int q = nwg / NXCD, r = nwg % NXCD, xcd = wgid % NXCD, off = wgid / NXCD; wgid = (xcd < r ? xcd * (q + 1) : r * (q + 1) + (xcd - r) * q) + off; }
        const int nig = WGM * nN, gid = wgid / nig, fm = gid * WGM, gsz = (nM - fm) < WGM ? (nM - fm) : WGM;
        u.pm = fm + ((wgid % nig) % gsz); u.pn = (wgid % nig) / gsz; return true;
    }
    __device__ __forceinline__ void a_ready(const Unit&) const {}
    __device__ __forceinline__ void done(const Unit&) const {}
};

__device__ __forceinline__ unsigned cvt_pk_bf16(float lo, float hi) { unsigned r; asm volatile("v_cvt_pk_bf16_f32 %0, %1, %2" : "=v"(r) : "v"(lo), "v"(hi)); return r; }
typedef float f32x2 __attribute__((ext_vector_type(2)));
__device__ __forceinline__ f32x2 gelu_pk(f32x2 v) {
    const f32x2 av = __builtin_elementwise_abs(v), d = av * 0.2316418882f + 1.0f;
    f32x2 t; t.x = __builtin_amdgcn_rcpf(d.x); t.y = __builtin_amdgcn_rcpf(d.y);
    f32x2 q = t * 0.5307027145f + (-0.7265760135f); q = q * t + 0.7107068705f; q = q * t + (-0.142248368f); q = q * t + 0.127414796f; q = q * t;
    const f32x2 s = (v * v) * (-0.72134752044f);
    f32x2 e; e.x = __builtin_amdgcn_exp2f(s.x); e.y = __builtin_amdgcn_exp2f(s.y);
    const f32x2 m = v * (q * e), r = v - m;
    f32x2 o; o.x = v.x < 0.f ? m.x : r.x; o.y = v.y < 0.f ? m.y : r.y; return o;
}

template <int ACT  > struct EpiBf16 {
    static constexpr bool PERM = true, AFTER_DRAIN = false; static_assert(ACT == 0 || ACT == 1, "EpiBf16: ACT is 0 (none) or 1 (gelu_pk)");
    bf16_t* O; int ldc; const float* bias; int split_cols; size_t split_stride; float scale0;
    __device__ __forceinline__ void operator()(const f32x4 (&acc)[2][2][4][2], const Unit& u, int wr, int wc, int fr, int fq) const {
        const int row0 = u.pm * BM + wr * 64 + fr; int colt = u.pn * BM; bf16_t* base = O;
        float sc = 1.f; if (split_cols) { const int t = colt / split_cols; base += (size_t)t * split_stride; colt -= t * split_cols; if (t == 0) sc = scale0; }
        const int col0 = colt + wc * 32 + 8 * fq, bcol0 = u.pn * BM + wc * 32 + 8 * fq;
        f32x4 bv[2][2];
#pragma unroll
        for (int bj = 0; bj < 2; ++bj)
#pragma unroll
            for (int n = 0; n < 2; ++n) bv[bj][n] = bias ? *(const f32x4*)(bias + bcol0 + bj * HALF + 4 * n) : (f32x4){0.f, 0.f, 0.f, 0.f};
#pragma unroll
        for (int ai = 0; ai < 2; ++ai)
#pragma unroll
            for (int m = 0; m < 4; ++m) { bf16_t* rowp = base + (size_t)(row0 + ai * HALF + m * 16) * ldc + col0;
#pragma unroll
                for (int bj = 0; bj < 2; ++bj) { f32x4 v0 = acc[ai][bj][m][0] + bv[bj][0], v1 = acc[ai][bj][m][1] + bv[bj][1];
                    if (ACT == 1) { f32x2 a = gelu_pk((f32x2){v0[0], v0[1]}), b = gelu_pk((f32x2){v0[2], v0[3]}), c = gelu_pk((f32x2){v1[0], v1[1]}), d = gelu_pk((f32x2){v1[2], v1[3]});
                        v0 = (f32x4){a.x, a.y, b.x, b.y}; v1 = (f32x4){c.x, c.y, d.x, d.y}; }
                    v0 = v0 * sc; v1 = v1 * sc; u32x4 w; w.x = cvt_pk_bf16(v0[0], v0[1]); w.y = cvt_pk_bf16(v0[2], v0[3]); w.z = cvt_pk_bf16(v1[0], v1[1]); w.w = cvt_pk_bf16(v1[2], v1[3]);
                    *(u32x4*)(rowp + bj * HALF) = w; } }
    }
};
struct EpiProj {
    static constexpr bool PERM = true, AFTER_DRAIN = false;
    bf16_t* O; int ldc;
    __device__ __forceinline__ void operator()(const f32x4 (&acc)[2][2][4][2], const Unit& u, int wr, int wc, int fr, int fq) const {
        const int row0 = u.pm * BM + wr * 64 + fr; const int col0 = u.pn * BM + wc * 32 + 8 * fq;
        const float sc = (u.pn < 4 || u.pn == 18 || u.pn == 19) ? 0.08838834764831845f : 1.0f;
#pragma unroll
        for (int ai = 0; ai < 2; ++ai)
#pragma unroll
            for (int m = 0; m < 4; ++m) { bf16_t* rowp = O + (size_t)(row0 + ai * HALF + m * 16) * ldc + col0;
#pragma unroll
                for (int bj = 0; bj < 2; ++bj) { f32x4 v0 = acc[ai][bj][m][0] * sc, v1 = acc[ai][bj][m][1] * sc;
                    u32x4 w; w.x = cvt_pk_bf16(v0[0], v0[1]); w.y = cvt_pk_bf16(v0[2], v0[3]); w.z = cvt_pk_bf16(v1[0], v1[1]); w.w = cvt_pk_bf16(v1[2], v1[3]);
                    *(u32x4*)(rowp + bj * HALF) = w; } }
    }
};
struct EpiResid {
    static constexpr bool PERM = false, AFTER_DRAIN = false;
    const float* base; float* out; const float* gate; int ldc, rows_per_batch, gate_stride;
    __device__ __forceinline__ void operator()(const f32x4 (&acc)[2][2][4][2], const Unit& u, int wr, int wc, int fr, int fq) const {
        const int col0 = u.pn * BM + wc * 32 + 4 * fq; const int b = (u.pm * BM) / rows_per_batch;
        f32x4 gv[2][2];
#pragma unroll
        for (int bj = 0; bj < 2; ++bj)
#pragma unroll
            for (int n = 0; n < 2; ++n) gv[bj][n] = *(const f32x4*)(gate + (size_t)b * gate_stride + col0 + bj * HALF + n * 16);
#pragma unroll
        for (int ai = 0; ai < 2; ++ai)
#pragma unroll
            for (int m = 0; m < 4; ++m) { const size_t off = (size_t)(u.pm * BM + ai * HALF + wr * 64 + m * 16 + fr) * ldc + col0;
#pragma unroll
                for (int bj = 0; bj < 2; ++bj)
#pragma unroll
                    for (int n = 0; n < 2; ++n) { const f32x4 bs = *(const f32x4*)(base + off + bj * HALF + n * 16);
                        *(f32x4*)(out + off + bj * HALF + n * 16) = bs + gv[bj][n] * acc[ai][bj][m][n]; } }
    }
};
template <class Epi, class Sched, bool ALIGN_EPI = false, bool SP2 = false>
__device__ __forceinline__ void gemm_phase(PG8_LAS unsigned char* lds, const Gemm g, const Sched& S, const Epi& E) {
    const int tid = threadIdx.x, wid = __builtin_amdgcn_readfirstlane(tid >> 6), lane = tid & 63, wr = wid >> 2, wc = wid & 3, fr = lane & 15, fq = lane >> 4;
    const int K = g.K, nt = K / BK;
    unsigned voffA[2], voffB[2];
#pragma unroll
    for (int i = 0; i < 2; ++i) { int R, C; stage_rc(tid * 16 + i * 8192, R, C); const int Rb = Epi::PERM ? ((R & ~31) + perm32(R & 31)) : R;
        voffA[i] = (unsigned)(R * K + C) * 2u; voffB[i] = (unsigned)(Rb * K + C) * 2u; }
    const size_t kstep = (size_t)(BK * 2);
    const size_t hstep = (size_t)HALF * K * 2;
    const size_t tstep = 2 * hstep;
    const unsigned ldsw = (unsigned)wid * 1024u;
    const int aoff = lds_byte(wr * 64 + fr, fq * 8), boff = lds_byte(wc * 32 + fr, fq * 8);
#define PG8_SA(b, h) (((b) * 2 + (h)) * HTB)
#define PG8_SB(b, h) ((4 + (b) * 2 + (h)) * HTB)
#define PG8_STAGE(bufoff, gbase, voff) do { _Pragma("unroll") for (int _i = 0; _i < 2; ++_i) \
        __builtin_amdgcn_global_load_lds((const unsigned*)((const char*)(gbase) + (voff)[_i]), (PG8_LAS unsigned*)(lds + (bufoff) + ldsw + _i * 8192), 16, 0, 0); } while (0)
#define PG8_LDA(dst, b, h) do { _Pragma("unroll") for (int m = 0; m < 4; ++m) _Pragma("unroll") for (int k = 0; k < 2; ++k) dst[m][k] = *(const PG8_LAS bf16x8*)(lds + PG8_SA(b, h) + aoff + m * 2048 + k * 1024); } while (0)
#define PG8_LDB(dst, b, h) do { _Pragma("unroll") for (int n = 0; n < 2; ++n) _Pragma("unroll") for (int k = 0; k < 2; ++k) dst[n][k] = *(const PG8_LAS bf16x8*)(lds + PG8_SB(b, h) + boff + n * 2048 + k * 1024); } while (0)
#define PG8_MMA(ai, bj, At, Bt) do { __builtin_amdgcn_s_setprio(1); _Pragma("unroll") for (int m = 0; m < 4; ++m) _Pragma("unroll") for (int n = 0; n < 2; ++n) _Pragma("unroll") for (int k = 0; k < 2; ++k) \
        acc[ai][bj][m][n] = __builtin_amdgcn_mfma_f32_16x16x32_bf16(Bt[n][k], At[m][k], acc[ai][bj][m][n], 0, 0, 0); __builtin_amdgcn_s_setprio(0); } while (0)
#define PG8_WAIT_V(n) asm volatile("s_waitcnt vmcnt(" #n ")" ::: "memory")
#define PG8_WAIT_L(n) asm volatile("s_waitcnt lgkmcnt(" #n ")" ::: "memory")
#define PG8_BAR __builtin_amdgcn_s_barrier()
#define PG8_SCHED __builtin_amdgcn_sched_barrier(0)
    Unit cur, nxt; int ui = 0;
    if (!S.next(0, cur)) return;
    f32x4 acc[2][2][4][2];
#pragma unroll
    for (int a = 0; a < 2; ++a)
#pragma unroll
        for (int b = 0; b < 2; ++b)
#pragma unroll
            for (int m = 0; m < 4; ++m)
#pragma unroll
                for (int n = 0; n < 2; ++n) acc[a][b][m][n] = (f32x4){0.f, 0.f, 0.f, 0.f};
    bf16x8 At[4][2], B0[2][2], B1[2][2];
    const char* cA = (const char*)g.A + (size_t)cur.pm * tstep; const char* cB = (const char*)g.Bt + (size_t)cur.pn * tstep;
    S.a_ready(cur);
    if constexpr (SP2) {
        PG8_STAGE(PG8_SB(0, 0), cB, voffB); PG8_STAGE(PG8_SB(0, 1), cB + hstep, voffB); PG8_STAGE(PG8_SA(0, 0), cA, voffA); PG8_STAGE(PG8_SA(0, 1), cA + hstep, voffA);
        if (wr == 1) PG8_BAR;
        PG8_WAIT_V(2); PG8_BAR;
        PG8_STAGE(PG8_SB(1, 0), cB + kstep, voffB); PG8_STAGE(PG8_SA(1, 0), cA + kstep, voffA); PG8_STAGE(PG8_SB(1, 1), cB + hstep + kstep, voffB);
        PG8_WAIT_V(6); PG8_BAR;
    } else {
        PG8_STAGE(PG8_SB(0, 0), cB, voffB); PG8_STAGE(PG8_SA(0, 0), cA, voffA); PG8_STAGE(PG8_SB(0, 1), cB + hstep, voffB); PG8_STAGE(PG8_SA(0, 1), cA + hstep, voffA);
        if (wr == 1) PG8_BAR;
        PG8_WAIT_V(4); PG8_BAR;
        PG8_STAGE(PG8_SB(1, 0), cB + kstep, voffB); PG8_STAGE(PG8_SA(1, 0), cA + kstep, voffA); PG8_STAGE(PG8_SB(1, 1), cB + hstep + kstep, voffB);
        PG8_WAIT_V(6); PG8_BAR;
    }
    for (;;) {
        const bool has_next = S.next(ui + 1, nxt);
        const char* nA = has_next ? (const char*)g.A + (size_t)nxt.pm * tstep : cA; const char* nB = has_next ? (const char*)g.Bt + (size_t)nxt.pn * tstep : cB;
        for (int t = 0; t < nt; t += 2) {
            const bool last = (t == nt - 2);
            const char* a1 = cA + (size_t)(t + 1) * kstep;
            const char* a2 = last ? nA : cA + (size_t)(t + 2) * kstep; const char* b2 = last ? nB : cB + (size_t)(t + 2) * kstep;
            const char* a3 = a2 + kstep; const char* b3 = b2 + kstep;
            if (last && has_next) S.a_ready(nxt);
            if constexpr (SP2) {
            PG8_LDB(B0, 0, 0); PG8_LDB(B1, 0, 1); PG8_SCHED; PG8_LDA(At, 0, 0); PG8_STAGE(PG8_SA(1, 1), a1 + hstep, voffA);
            PG8_WAIT_V(8); PG8_WAIT_L(0); PG8_BAR; PG8_MMA(0, 0, At, B0); PG8_MMA(0, 1, At, B1); PG8_BAR; PG8_SCHED;
            PG8_LDA(At, 0, 1); PG8_STAGE(PG8_SB(0, 0), b2, voffB); PG8_STAGE(PG8_SB(0, 1), b2 + hstep, voffB); PG8_STAGE(PG8_SA(0, 0), a2, voffA);
            PG8_WAIT_V(8); PG8_WAIT_L(0); PG8_BAR; PG8_MMA(1, 0, At, B0); PG8_MMA(1, 1, At, B1); PG8_BAR; PG8_SCHED;
            PG8_LDB(B0, 1, 0); PG8_LDB(B1, 1, 1); PG8_SCHED; PG8_LDA(At, 1, 0); PG8_STAGE(PG8_SA(0, 1), a2 + hstep, voffA);
            PG8_WAIT_V(8); PG8_WAIT_L(0); PG8_BAR; PG8_MMA(0, 0, At, B0); PG8_MMA(0, 1, At, B1); PG8_BAR; PG8_SCHED;
            PG8_LDA(At, 1, 1); PG8_STAGE(PG8_SB(1, 0), b3, voffB); PG8_STAGE(PG8_SB(1, 1), b3 + hstep, voffB); PG8_STAGE(PG8_SA(1, 0), a3, voffA);
            PG8_WAIT_V(8); PG8_WAIT_L(0); PG8_BAR; PG8_MMA(1, 0, At, B0); PG8_MMA(1, 1, At, B1); PG8_BAR; PG8_SCHED;
            } else {
            PG8_LDB(B0, 0, 0); PG8_SCHED; PG8_LDA(At, 0, 0); PG8_STAGE(PG8_SA(1, 1), a1 + hstep, voffA);
            PG8_WAIT_L(8); PG8_BAR; PG8_WAIT_L(0); PG8_MMA(0, 0, At, B0); PG8_BAR; PG8_SCHED;
            PG8_LDB(B1, 0, 1); PG8_STAGE(PG8_SB(0, 0), b2, voffB);
            PG8_BAR; PG8_WAIT_L(0); PG8_MMA(0, 1, At, B1); PG8_BAR;
            PG8_LDA(At, 0, 1); PG8_STAGE(PG8_SA(0, 0), a2, voffA);
            PG8_BAR; PG8_WAIT_L(0); PG8_MMA(1, 0, At, B0); PG8_BAR; PG8_SCHED;
            PG8_STAGE(PG8_SB(0, 1), b2 + hstep, voffB);
            PG8_WAIT_V(6); PG8_BAR; PG8_MMA(1, 1, At, B1); PG8_BAR;
            PG8_LDB(B0, 1, 0); PG8_SCHED; PG8_LDA(At, 1, 0); PG8_STAGE(PG8_SA(0, 1), a2 + hstep, voffA);
            PG8_WAIT_L(8); PG8_BAR; PG8_WAIT_L(0); PG8_MMA(0, 0, At, B0); PG8_BAR; PG8_SCHED;
            PG8_LDB(B1, 1, 1); PG8_STAGE(PG8_SB(1, 0), b3, voffB);
            PG8_BAR; PG8_WAIT_L(0); PG8_MMA(0, 1, At, B1); PG8_BAR;
            PG8_LDA(At, 1, 1); PG8_STAGE(PG8_SA(1, 0), a3, voffA);
            PG8_BAR; PG8_WAIT_L(0); PG8_MMA(1, 0, At, B0); PG8_BAR; PG8_SCHED;
            PG8_STAGE(PG8_SB(1, 1), b3 + hstep, voffB);
            PG8_WAIT_V(6); PG8_BAR; PG8_MMA(1, 1, At, B1); PG8_BAR;
            }
        }
        if constexpr (ALIGN_EPI) { if (wr == 0) PG8_BAR; }
        if constexpr (!Epi::AFTER_DRAIN) { E(acc, cur, wr, wc, fr, fq); S.done(cur); }
        if (!has_next) break;
#pragma unroll
        for (int a = 0; a < 2; ++a)
#pragma unroll
            for (int b = 0; b < 2; ++b)
#pragma unroll
                for (int m = 0; m < 4; ++m)
#pragma unroll
                    for (int n = 0; n < 2; ++n) acc[a][b][m][n] = (f32x4){0.f, 0.f, 0.f, 0.f};
        cur = nxt; cA = nA; cB = nB; ++ui;
        if constexpr (ALIGN_EPI) { if (wr == 1) PG8_BAR; }
    }
    PG8_WAIT_V(0);
    if constexpr (!ALIGN_EPI) { if (wr == 0) PG8_BAR; }
    PG8_BAR;
    if constexpr (Epi::AFTER_DRAIN) { E.fused(acc, cur, wr, wc, fr, fq, lds, wid, lane); S.done(cur); }
#undef PG8_SA
#undef PG8_SB
#undef PG8_STAGE
#undef PG8_LDA
#undef PG8_LDB
#undef PG8_MMA
#undef PG8_WAIT_V
#undef PG8_WAIT_L
#undef PG8_BAR
#undef PG8_SCHED
}
}
#define GAS __attribute__((address_space(1)))
#define LAS __attribute__((address_space(3)))
typedef unsigned short bf16;
typedef unsigned v4u __attribute__((ext_vector_type(4)));
typedef float f32x4 __attribute__((ext_vector_type(4)));
typedef short bf16x8 __attribute__((ext_vector_type(8)));
typedef GAS unsigned gu32;
typedef GAS unsigned long long gu64;
#define RLX_AGENT __ATOMIC_RELAXED, __HIP_MEMORY_SCOPE_AGENT
#define LDS_WAIT() asm volatile("s_waitcnt lgkmcnt(0)" ::: "memory")
#define VM_WAIT() asm volatile("s_waitcnt vmcnt(0)" ::: "memory")
__device__ __forceinline__ unsigned long long rt() { return __builtin_amdgcn_s_memrealtime(); }
__device__ __forceinline__ unsigned f2bf(float f) { unsigned u = __builtin_bit_cast(unsigned, f); return (u + 0x7fffu + ((u >> 16) & 1u)) >> 16; }
__device__ __forceinline__ unsigned pk2(float lo, float hi) { return f2bf(lo) | (f2bf(hi) << 16); }

#define XB_TMO      128
#define XB_XCNT(j)  (256  + 64 * (j))
#define XB_XSUB(j)  (1280 + 64 * (j))
#define XB_XGEN(j)  (2304 + 64 * (j))
#define XB_TOP      3328
#define XB_TOPGEN   3392
#define XCD_BAR_WORDS 3456
#define XB_SPIN_CAP (1u << 18)

__device__ __forceinline__ unsigned xb_ld(unsigned* p)              { return __hip_atomic_load(p, __ATOMIC_RELAXED, __HIP_MEMORY_SCOPE_AGENT); }
__device__ __forceinline__ unsigned xb_add(unsigned* p, unsigned v) { return __hip_atomic_fetch_add(p, v, __ATOMIC_RELAXED, __HIP_MEMORY_SCOPE_AGENT); }
__device__ __forceinline__ unsigned xb_xcc_id() { return (unsigned)__builtin_amdgcn_s_getreg((3 << 11) | 20) & 0xFu; }
#define XB_SPIN(cond, bar) do { unsigned _sp = 0; while (cond) { __builtin_amdgcn_s_sleep(1); \
    if ((++_sp & 255u) == 0u) { if (xb_ld(&(bar)[XB_TMO])) break; if (_sp > XB_SPIN_CAP) { atomicAdd(&(bar)[XB_TMO], 1u); break; } } } } while (0)

struct XcdBarrier {
    unsigned* bar; unsigned x;
    volatile LAS unsigned* st;
};

__device__ __forceinline__ XcdBarrier xcd_barrier_post(unsigned* bar, volatile LAS unsigned* st) {
    XcdBarrier b; b.bar = bar; b.x = xb_xcc_id(); b.st = st;
    if (threadIdx.x == 0) (void)xb_add(&bar[XB_XCNT(b.x)], 1u);
    return b;
}
__device__ __forceinline__ void xcd_barrier_complete(unsigned* bar, unsigned x, unsigned& nloc, unsigned& nx) {
    const unsigned G = gridDim.x * gridDim.y * gridDim.z;
    unsigned sum, cnt, mine, sp = 0u;
    for (;;) {
        sum = 0u; cnt = 0u; mine = 0u;
#pragma unroll
        for (unsigned j = 0; j < 16; ++j) { const unsigned c = xb_ld(&bar[XB_XCNT(j)]); sum += c; cnt += (c > 0u) ? 1u : 0u; mine = (j == x) ? c : mine; }
        if (sum == G) break;
        __builtin_amdgcn_s_sleep(1);
        if ((++sp & 255u) == 0u) { if (xb_ld(&bar[XB_TMO])) break; if (sp > XB_SPIN_CAP) { atomicAdd(&bar[XB_TMO], 1u); break; } }
    }
    nloc = mine > 0u ? mine : 1u; nx = cnt > 0u ? cnt : 1u;
}

__device__ __forceinline__ void xcd_barrier(const XcdBarrier& b) {
    asm volatile("s_waitcnt vmcnt(0)" ::: "memory");
    __syncthreads();
    if (threadIdx.x == 0) {
        unsigned* bar = b.bar;
        __builtin_amdgcn_s_waitcnt(0);
        unsigned nloc = b.st[0], nx = b.st[1];
        if (nloc == 0u) { xcd_barrier_complete(bar, b.x, nloc, nx); b.st[0] = nloc; b.st[1] = nx; }
        const unsigned old = xb_add(&bar[XB_XSUB(b.x)], 1u);
        const unsigned gen = old / nloc;
        if (old + 1u == (gen + 1u) * nloc) {
            __builtin_amdgcn_fence(__ATOMIC_RELEASE, "agent");
            asm volatile("s_waitcnt vmcnt(0)" ::: "memory");
            const unsigned og = xb_add(&bar[XB_TOP], 1u);
            const unsigned tg = og / nx;
            if (og + 1u == (tg + 1u) * nx) xb_add(&bar[XB_TOPGEN], 1u);
            else XB_SPIN(xb_ld(&bar[XB_TOPGEN]) == tg, bar);
            __builtin_amdgcn_fence(__ATOMIC_ACQUIRE, "agent");
            xb_add(&bar[XB_XGEN(b.x)], 1u);
            asm volatile("s_waitcnt vmcnt(0)" ::: "memory");
        } else {
            XB_SPIN(xb_ld(&bar[XB_XGEN(b.x)]) == gen, bar);
            __builtin_amdgcn_fence(__ATOMIC_ACQUIRE, "agent");
            asm volatile("s_waitcnt vmcnt(0)" ::: "memory");
        }
    }
    __syncthreads();
}
constexpr int NWAVES = 8;
constexpr int NB = 2, SEQ = 4096, M = NB * SEQ, D = 2048, NP = 7168, DEPTH = 4, MODW = 3 * D;
constexpr int C_QA = 0, C_KA = 1024, C_VA = 2048, C_ZA = 3072, C_QR = 4096, C_KR = 4608, C_VR = 5120, C_ZR = 6144;
constexpr float EPS = 1e-6f;
#ifndef ONE_LAUNCH
#define ONE_LAUNCH 1
#endif
#ifndef NAIVE_ATT
#define NAIVE_ATT 1
#endif
#ifndef NAIVE_RET
#define NAIVE_RET 1
#endif
constexpr size_t MiB = 1u << 20;
constexpr size_t WS_CTL = 0, CTL_ZERO_BYTES = 64 * 1024;
constexpr size_t WS_MOD = 1 * MiB;
constexpr size_t WS_WIN = 2 * MiB;
constexpr size_t WS_WOUT = 114 * MiB;
constexpr size_t WS_HN = 146 * MiB;
constexpr size_t WS_PROJ = 178 * MiB;
constexpr size_t WS_Y = 290 * MiB;
constexpr size_t WS_X = 322 * MiB;
constexpr size_t WS_RET = 386 * MiB;
constexpr size_t WS_END = 482 * MiB;
constexpr int CW_BAR = 1024;
static_assert((CW_BAR + XCD_BAR_WORDS) * 4 <= (int)CTL_ZERO_BYTES, "CTL");
constexpr int RING_BYTES = 131072, MISC_OFF = RING_BYTES + 320, LDS_BYTES = 147456;

__device__ __forceinline__ float bf2f(unsigned u) { return __uint_as_float(u << 16); }
__device__ __forceinline__ float silu_f(float v) { return v / (1.0f + __expf(-v)); }
__device__ __forceinline__ float wave_sum(float v) {
#pragma unroll
    for (int o = 1; o < 64; o <<= 1) v += __shfl_xor(v, o);
    return v;
}
__device__ __forceinline__ float wave_max(float v) {
#pragma unroll
    for (int o = 1; o < 64; o <<= 1) v = fmaxf(v, __shfl_xor(v, o));
    return v;
}

__device__ __forceinline__ void p0_gemv(const float* c, const float* w_ada, const float* b_ada, float* MOD, LAS unsigned char* lds, int g, int tid) {
    const int wave = tid >> 6, lane = tid & 63, rs = lane >> 3, cgp = lane & 7;
    const int l = g >> 6, col0 = (g & 63) * 96;
    const float* W = w_ada + (size_t)l * D * MODW + col0 + cgp * 12;
    float a0[12], a1[12];
#pragma unroll
    for (int j = 0; j < 12; ++j) { a0[j] = 0.f; a1[j] = 0.f; }
#pragma unroll 4
    for (int it = 0; it < 32; ++it) {
        const int k = wave * 256 + it * 8 + rs;
        const float s0 = silu_f(c[k]), s1 = silu_f(c[D + k]);
        const f32x4* wp = (const f32x4*)(W + (size_t)k * MODW);
        const f32x4 w0 = wp[0], w1 = wp[1], w2 = wp[2];
#pragma unroll
        for (int j = 0; j < 4; ++j) { a0[j] += s0 * w0[j]; a0[4 + j] += s0 * w1[j]; a0[8 + j] += s0 * w2[j]; a1[j] += s1 * w0[j]; a1[4 + j] += s1 * w1[j]; a1[8 + j] += s1 * w2[j]; }
    }
#pragma unroll
    for (int j = 0; j < 12; ++j) {
        a0[j] += __shfl_xor(a0[j], 8); a0[j] += __shfl_xor(a0[j], 16); a0[j] += __shfl_xor(a0[j], 32);
        a1[j] += __shfl_xor(a1[j], 8); a1[j] += __shfl_xor(a1[j], 16); a1[j] += __shfl_xor(a1[j], 32);
    }
    LAS float* red = (LAS float*)lds;
    if (rs == 0) {
#pragma unroll
        for (int j = 0; j < 12; ++j) { red[(wave * 2 + 0) * 96 + cgp * 12 + j] = a0[j]; red[(wave * 2 + 1) * 96 + cgp * 12 + j] = a1[j]; }
    }
    __syncthreads();
    if (tid < 192) { const int b = tid / 96, j = tid % 96; float s = b_ada[l * MODW + col0 + j];
#pragma unroll
        for (int w = 0; w < 8; ++w) s += red[(w * 2 + b) * 96 + j];
        MOD[(size_t)(l * 2 + b) * MODW + col0 + j] = s; }
    __syncthreads();
}
__device__ __forceinline__ void p0_transpose_item(const float* W, int K, int N, bf16* WT, LAS float* scr, int item, int lane) {
    const int nblk = N / 32, kb = item / nblk, nb = item % nblk, k0 = 64 * kb, n0 = 32 * nb;
#pragma unroll 8
    for (int i = 0; i < 32; ++i) { const int kk = 2 * i + (lane >> 5); scr[kk * 33 + (lane & 31)] = W[(size_t)(k0 + kk) * N + n0 + (lane & 31)]; }
    LDS_WAIT(); asm volatile("" ::: "memory");
    const int c = lane & 7;
#pragma unroll
    for (int j = 0; j < 4; ++j) { const int n = (lane >> 3) + 8 * j; const LAS float* s = scr + (8 * c) * 33 + n;
        v4u o; o.x = pk2(s[0 * 33], s[1 * 33]); o.y = pk2(s[2 * 33], s[3 * 33]); o.z = pk2(s[4 * 33], s[5 * 33]); o.w = pk2(s[6 * 33], s[7 * 33]);
        *(GAS v4u*)(WT + (size_t)(n0 + n) * K + k0 + 8 * c) = o; }
    LDS_WAIT(); asm volatile("" ::: "memory");
}
__device__ __forceinline__ void p0_transposes(const float* w_in, const float* w_out, bf16* WIN_T, bf16* WOUT_T, LAS unsigned char* lds, int gw, int NGW, int wave, int lane) {
    LAS float* scr = (LAS float*)(lds + wave * 16384);
    constexpr int I_IN = (D / 64) * (NP / 32), I_OUT = (D / 64) * (D / 32), I_L = I_IN + I_OUT;
    for (int it = gw; it < DEPTH * I_L; it += NGW) {
        const int l = it / I_L; int r = it % I_L;
        if (r < I_IN) p0_transpose_item(w_in + (size_t)l * D * NP, D, NP, WIN_T + (size_t)l * NP * D, scr, r, lane);
        else p0_transpose_item(w_out + (size_t)l * D * D, D, D, WOUT_T + (size_t)l * D * D, scr, r - I_IN, lane);
    }
}

template <bool FINAL>
__device__ __forceinline__ void norm_rows(const float* src, const float* gain, const float* mod, bf16* outb, float* outf, int gw, int NGW, int lane) {
    for (int m = gw; m < M; m += NGW) {
        const f32x4* xr = (const f32x4*)(src + (size_t)m * D) + lane;
        f32x4 v[8]; float ss = 0.f;
#pragma unroll
        for (int j = 0; j < 8; ++j) { v[j] = xr[64 * j]; ss += (v[j].x * v[j].x + v[j].y * v[j].y) + (v[j].z * v[j].z + v[j].w * v[j].w); }
        const float rstd = rsqrtf(wave_sum(ss) * (1.0f / D) + EPS);
        const int b = m / SEQ;
#pragma unroll
        for (int j = 0; j < 8; ++j) {
            const int col = 4 * (lane + 64 * j);
            const f32x4 g4 = *(const f32x4*)(gain + col);
            f32x4 y = v[j] * rstd * g4;
            if constexpr (FINAL) { *(f32x4*)(outf + (size_t)m * D + col) = y; }
            else {
                const f32x4 sh = *(const f32x4*)(mod + (size_t)b * MODW + col), sc = *(const f32x4*)(mod + (size_t)b * MODW + D + col);
                y = y * (sc + 1.0f) + sh;
                *(unsigned long long*)(outb + (size_t)m * D + col) = (unsigned long long)pk2(y.x, y.y) | ((unsigned long long)pk2(y.z, y.w) << 32);
            }
        }
    }
}

__device__ __forceinline__ void attn_naive(const bf16* PROJ, bf16* Y, LAS unsigned char* lds, int gw, int NGW, int wave, int lane) {
    LAS float* qs = (LAS float*)(lds + wave * 4096);
    LAS float* ps = qs + 128;
    for (int item = gw; item < M * 8; item += NGW) {
        const int m = item >> 3, h = item & 7, b = m / SEQ, t = m % SEQ;
        const float slope = exp2f(-(float)(h + 1));
        { const unsigned qq = *(const unsigned*)(PROJ + (size_t)m * NP + C_QA + h * 128 + 2 * lane); qs[2 * lane] = bf2f(qq & 0xffffu); qs[2 * lane + 1] = bf2f(qq >> 16); }
        LDS_WAIT(); asm volatile("" ::: "memory");
        float sc[7]; float mx = -1e30f;
#pragma unroll
        for (int r = 0; r < 7; ++r) {
            const int i = lane + 64 * r; const int p = i / 129, j = i % 129 - 64; const int dil = (p == 0) ? 1 : ((p == 1) ? 4 : 16);
            const int off = j * dil, s = t + off; const bool valid = (i < 387) && (s >= 0) && (s < SEQ);
            float dot = 0.f;
            if (valid) {
                const bf16* kr = PROJ + (size_t)(b * SEQ + s) * NP + C_KA + h * 128;
#pragma unroll 4
                for (int c8 = 0; c8 < 16; ++c8) { const v4u kk = *(const v4u*)(kr + 8 * c8); const f32x4 q0 = *(const LAS f32x4*)(qs + 8 * c8), q1 = *(const LAS f32x4*)(qs + 8 * c8 + 4);
                    dot += q0.x * bf2f(kk.x & 0xffffu) + q0.y * bf2f(kk.x >> 16) + q0.z * bf2f(kk.y & 0xffffu) + q0.w * bf2f(kk.y >> 16)
                         + q1.x * bf2f(kk.z & 0xffffu) + q1.y * bf2f(kk.z >> 16) + q1.z * bf2f(kk.w & 0xffffu) + q1.w * bf2f(kk.w >> 16); }
            }
            sc[r] = valid ? dot - slope * fabsf((float)off) : -1e30f;
            mx = fmaxf(mx, sc[r]);
        }
        mx = wave_max(mx);
        float lsum = 0.f;
#pragma unroll
        for (int r = 0; r < 7; ++r) { const float pr = __expf(sc[r] - mx); lsum += pr; ps[lane + 64 * r] = pr; }
        lsum = wave_sum(lsum);
        LDS_WAIT(); asm volatile("" ::: "memory");
        float o0 = 0.f, o1 = 0.f;
        for (int p = 0; p < 3; ++p) { const int dil = (p == 0) ? 1 : ((p == 1) ? 4 : 16);
#pragma unroll 8
            for (int jj = 0; jj < 129; ++jj) { int s = t + (jj - 64) * dil; s = s < 0 ? 0 : (s >= SEQ ? SEQ - 1 : s);
                const float pv = ps[p * 129 + jj];
                const unsigned vv = *(const unsigned*)(PROJ + (size_t)(b * SEQ + s) * NP + C_VA + h * 128 + 2 * lane);
                o0 += pv * bf2f(vv & 0xffffu); o1 += pv * bf2f(vv >> 16); } }
        const unsigned zz = *(const unsigned*)(PROJ + (size_t)m * NP + C_ZA + h * 128 + 2 * lane);
        const float inv = 1.0f / lsum;
        *(unsigned*)(Y + (size_t)m * D + h * 128 + 2 * lane) = pk2(o0 * inv * silu_f(bf2f(zz & 0xffffu)), o1 * inv * silu_f(bf2f(zz >> 16)));
        LDS_WAIT(); asm volatile("" ::: "memory");
    }
}

__device__ __forceinline__ void ret_naive_scan(const bf16* PROJ, const float* dec_f, const float* dec_b, float* OUT, LAS unsigned char* lds, int unit, int tid) {
    const int dir = unit >> 3, b = (unit >> 2) & 1, h = unit & 3;
    const float logit = dir ? dec_b[h] : dec_f[h]; const float gamma = 1.0f / (1.0f + __expf(-logit));
    const int e = tid & 255, half = tid >> 8;
    LAS float* qk = (LAS float*)lds;
    LAS float* red = qk + 512;
    float S[64];
#pragma unroll
    for (int d = 0; d < 64; ++d) S[d] = 0.f;
    const int qkcol = (tid < 128) ? (C_QR + h * 128 + tid) : (C_KR + h * 128 + (tid & 127));
    int t0 = dir ? SEQ - 1 : 0;
    unsigned short nqk = PROJ[(size_t)(b * SEQ + t0) * NP + qkcol], nv = PROJ[(size_t)(b * SEQ + t0) * NP + C_VR + h * 256 + e];
    for (int step = 0; step < SEQ; ++step) {
        const int t = dir ? SEQ - 1 - step : step, m = b * SEQ + t, buf = step & 1;
        if (tid < 256) qk[buf * 256 + tid] = bf2f(nqk);
        const float ve = bf2f(nv);
        if (step + 1 < SEQ) { const int tn = dir ? t - 1 : t + 1; nqk = PROJ[(size_t)(b * SEQ + tn) * NP + qkcol]; nv = PROJ[(size_t)(b * SEQ + tn) * NP + C_VR + h * 256 + e]; }
        __syncthreads();
        float part = 0.f;
        const LAS float* qp = qk + buf * 256 + 64 * half; const LAS float* kp = qp + 128;
#pragma unroll
        for (int d = 0; d < 64; ++d) { S[d] = gamma * S[d] + kp[d] * ve; part += qp[d] * S[d]; }
        if (half == 1) red[buf * 256 + e] = part;
        __syncthreads();
        if (half == 0) OUT[((size_t)dir * M + m) * 1024 + h * 256 + e] = part + red[buf * 256 + e];
    }
}
__device__ __forceinline__ void ret_naive_combine(const float* OUT, const bf16* PROJ, bf16* Y, int gw, int NGW, int lane) {
    for (int item = gw; item < M * 4; item += NGW) {
        const int m = item >> 2, h = item & 3;
        const f32x4 a = *(const f32x4*)(OUT + (size_t)m * 1024 + h * 256 + 4 * lane), bq = *(const f32x4*)(OUT + ((size_t)M + m) * 1024 + h * 256 + 4 * lane);
        const f32x4 o = a + bq;
        const float r = rsqrtf(wave_sum((o.x * o.x + o.y * o.y) + (o.z * o.z + o.w * o.w)) * (1.0f / 256.0f) + EPS);
        const unsigned long long zz = *(const unsigned long long*)(PROJ + (size_t)m * NP + C_ZR + h * 256 + 4 * lane);
        const unsigned z0 = (unsigned)zz, z1 = (unsigned)(zz >> 32);
        const float y0 = o.x * r * silu_f(bf2f(z0 & 0xffffu)), y1 = o.y * r * silu_f(bf2f(z0 >> 16)), y2 = o.z * r * silu_f(bf2f(z1 & 0xffffu)), y3 = o.w * r * silu_f(bf2f(z1 >> 16));
        *(unsigned long long*)(Y + (size_t)m * D + 1024 + h * 256 + 4 * lane) = (unsigned long long)pk2(y0, y1) | ((unsigned long long)pk2(y2, y3) << 32);
    }
}

struct Args { const float* in[10]; float* out; unsigned char* ws; int ph_lo, ph_hi, use_bar, pad; };
constexpr int N_PHASES = 2 + 5 * DEPTH;

__device__ __forceinline__ unsigned char* ld_ptr(volatile LAS unsigned* tab, int i) {
    unsigned lo = tab[2 * i], hi = tab[2 * i + 1];
    lo = __builtin_amdgcn_readfirstlane(lo); hi = __builtin_amdgcn_readfirstlane(hi);
    return (unsigned char*)(((unsigned long long)hi << 32) | lo);
}
__global__ void __launch_bounds__(NWAVES * 64, 2) fwd_kernel(Args args) {
    extern __shared__ __attribute__((aligned(16))) unsigned char lds_raw[];
    LAS unsigned char* lds = (LAS unsigned char*)lds_raw;
    const int tid = threadIdx.x;
    volatile LAS unsigned* MISC = (volatile LAS unsigned*)(lds + MISC_OFF);
    volatile LAS unsigned* TAB = MISC + 32;
    for (int u = tid; u < (LDS_BYTES - RING_BYTES) / 4; u += NWAVES * 64) ((LAS unsigned*)(lds + RING_BYTES))[u] = 0u;
    __syncthreads();
    if (tid < 12) { const unsigned long long v = (tid < 10) ? (unsigned long long)args.in[tid] : (tid == 10 ? (unsigned long long)args.out : (unsigned long long)args.ws);
        TAB[2 * tid] = (unsigned)v; TAB[2 * tid + 1] = (unsigned)(v >> 32); }
    __syncthreads();
    if (tid == 0) { MISC[11] = (unsigned)args.ph_lo; MISC[12] = (unsigned)args.ph_hi; MISC[13] = (unsigned)args.use_bar; }
    if (args.use_bar) { const XcdBarrier b0 = xcd_barrier_post((unsigned*)(args.ws + WS_CTL) + CW_BAR, MISC + 8); if (tid == 0) MISC[10] = b0.x; }
    __syncthreads();
#define CFG(i) ((int)__builtin_amdgcn_readfirstlane(MISC[(i)]))
#define IN(k) (CFG(11) <= (k) && (k) < CFG(12))
#define GRID_BAR() do { if (CFG(13)) { XcdBarrier b_; b_.bar = (unsigned*)(ld_ptr(TAB, 11) + WS_CTL) + CW_BAR; b_.x = (unsigned)CFG(10); b_.st = MISC + 8; xcd_barrier(b_); } } while (0)
#define PTR(i) ld_ptr(TAB, (i))
#define WAVE_IDS() int t__ = threadIdx.x; asm volatile("" : "+v"(t__)); const int lane = t__ & 63, wave = __builtin_amdgcn_readfirstlane(t__ >> 6), gw = blockIdx.x * NWAVES + wave, NGW = gridDim.x * NWAVES

    if (IN(0)) {
        WAVE_IDS(); unsigned char* ws = PTR(11);
        p0_gemv((const float*)PTR(1), (const float*)PTR(3), (const float*)PTR(4), (float*)(ws + WS_MOD), lds, blockIdx.x, t__);
        p0_transposes((const float*)PTR(5), (const float*)PTR(6), (bf16*)(ws + WS_WIN), (bf16*)(ws + WS_WOUT), lds, gw, NGW, wave, lane);
        __syncthreads();
        if (CFG(13)) cg::this_grid().sync();
        GRID_BAR();
    }
    for (int l = 0; l < DEPTH; ++l) {
        const int pb = 1 + 5 * l;
        if (IN(pb + 0)) { WAVE_IDS(); unsigned char* ws = PTR(11);
            norm_rows<false>((l == 0) ? (const float*)PTR(0) : (const float*)(ws + WS_X), (const float*)PTR(2) + l * D, (const float*)(ws + WS_MOD) + (size_t)l * 2 * MODW, (bf16*)(ws + WS_HN), nullptr, gw, NGW, lane);
            GRID_BAR(); }
        if (IN(pb + 1)) { unsigned char* ws = PTR(11);
            pg8::Gemm g{(const bf16*)(ws + WS_HN), (const bf16*)(ws + WS_WIN) + (size_t)l * NP * D, M, NP, D}; pg8::StaticOrder S; S.init(M, NP, gridDim.x, blockIdx.x);
            pg8::EpiProj E{(bf16*)(ws + WS_PROJ), NP};
            pg8::gemm_phase<pg8::EpiProj, pg8::StaticOrder, true, true>(lds, g, S, E);
            GRID_BAR();
        }
        if (IN(pb + 2)) { WAVE_IDS(); unsigned char* ws = PTR(11);
#if NAIVE_RET
            if (blockIdx.x < 16) ret_naive_scan((const bf16*)(ws + WS_PROJ), (const float*)PTR(7) + l * 4, (const float*)PTR(8) + l * 4, (float*)(ws + WS_RET), lds, blockIdx.x, t__);
            __syncthreads();
#endif
#if NAIVE_ATT
            attn_naive((const bf16*)(ws + WS_PROJ), (bf16*)(ws + WS_Y), lds, gw, NGW, wave, lane);
#endif
            GRID_BAR();
        }
        if (IN(pb + 3)) { WAVE_IDS(); unsigned char* ws = PTR(11);
#if NAIVE_RET
            ret_naive_combine((const float*)(ws + WS_RET), (const bf16*)(ws + WS_PROJ), (bf16*)(ws + WS_Y), gw, NGW, lane);
#endif
            GRID_BAR();
        }
        if (IN(pb + 4)) { unsigned char* ws = PTR(11);
            pg8::Gemm g{(const bf16*)(ws + WS_Y), (const bf16*)(ws + WS_WOUT) + (size_t)l * D * D, M, D, D}; pg8::StaticOrder S; S.init(M, D, gridDim.x, blockIdx.x);
            pg8::EpiResid E{(l == 0) ? (const float*)PTR(0) : (const float*)(ws + WS_X), (float*)(ws + WS_X), (const float*)(ws + WS_MOD) + (size_t)l * 2 * MODW + 2 * D, D, SEQ, MODW};
            pg8::gemm_phase<pg8::EpiResid, pg8::StaticOrder, true, true>(lds, g, S, E);
            GRID_BAR();
        }
    }
    if (IN(N_PHASES - 1)) { WAVE_IDS(); unsigned char* ws = PTR(11);
        norm_rows<true>((const float*)(ws + WS_X), (const float*)PTR(9), nullptr, nullptr, (float*)PTR(10), gw, NGW, lane); }
#undef IN
#undef GRID_BAR
}

extern "C" void kernel_launch(void* const* d_in, const int* in_sizes, int n_in, void* d_out, int out_size, void* d_ws, size_t ws_size, hipStream_t stream) {
    static int grid = 0;
    if (grid == 0) {
        if (n_in != 10 || out_size != M * D || ws_size < WS_END) { fprintf(stderr, "kernel_launch: unexpected shapes (n_in %d out %d ws %zu)\n", n_in, out_size, ws_size); grid = -1; return; }
        int dev = 0, cus = 0, per_cu = 0;
        hipGetDevice(&dev); hipDeviceGetAttribute(&cus, hipDeviceAttributeMultiprocessorCount, dev);
        if (hipFuncSetAttribute((const void*)fwd_kernel, hipFuncAttributeMaxDynamicSharedMemorySize, LDS_BYTES) != hipSuccess) { fprintf(stderr, "kernel_launch: hipFuncSetAttribute failed\n"); grid = -1; return; }
        if (hipOccupancyMaxActiveBlocksPerMultiprocessor(&per_cu, (const void*)fwd_kernel, NWAVES * 64, LDS_BYTES) != hipSuccess || per_cu < 1) { fprintf(stderr, "kernel_launch: occupancy query says %d\n", per_cu); per_cu = 1; }
        (void)hipGetLastError();
        grid = cus * 1;
        fprintf(stderr, "kernel_launch: grid %d (cus %d, per_cu %d)\n", grid, cus, per_cu);
    }
    if (grid < 0) return;
    Args a{};
    for (int i = 0; i < 10; ++i) a.in[i] = (const float*)d_in[i];
    a.out = (float*)d_out; a.ws = (unsigned char*)d_ws;
#if ONE_LAUNCH
    if (hipMemsetAsync((char*)d_ws + WS_CTL, 0, CTL_ZERO_BYTES, stream) != hipSuccess) { fprintf(stderr, "kernel_launch: memset failed\n"); return; }
    a.ph_lo = 0; a.ph_hi = N_PHASES; a.use_bar = 1;
    void* kargs[] = {&a};
    hipError_t e = hipLaunchCooperativeKernel((const void*)fwd_kernel, dim3(grid), dim3(NWAVES * 64), kargs, LDS_BYTES, stream);
    if (e != hipSuccess) fprintf(stderr, "kernel_launch: cooperative launch failed: %s (grid %d)\n", hipGetErrorString(e), grid);
#else
    for (int ph = 0; ph < N_PHASES; ++ph) {
        a.ph_lo = ph; a.ph_hi = ph + 1; a.use_bar = 0;
        hipLaunchKernelGGL(fwd_kernel, dim3(grid), dim3(NWAVES * 64), LDS_BYTES, stream, a);
    }
#endif
}
```

```cpp
#include <hip/hip_runtime.h>
#include <hip/hip_cooperative_groups.h>
#include <cstdio>
#include <cstdint>
namespace cg = cooperative_groups;
#define ONE_LAUNCH 1
#define NAIVE_ATT 0
#define NAIVE_RET 0
namespace pg8 {
#define PG8_LAS __attribute__((address_space(3)))
typedef unsigned short bf16_t;
typedef short bf16x8 __attribute__((ext_vector_type(8)));
typedef float f32x4 __attribute__((ext_vector_type(4)));
typedef unsigned u32x4 __attribute__((ext_vector_type(4)));
constexpr int BM = 256, BK = 64, HALF = 128, HTB = HALF * BK * 2  , STAGE_BYTES = 8 * HTB, NXCD = 8, WGM = 8;

__host__ __device__ __forceinline__ int lds_byte(int r, int c) { const int st = (r >> 4) * 2 + (c >> 5), rr = r & 15, cc = c & 31, ob = rr * 64 + cc * 2; return st * 1024 + (ob ^ (((ob >> 9) & 1) << 5)); }
__host__ __device__ __forceinline__ void stage_rc(int b, int& R, int& C) { const int st = b / 1024, sb = b % 1024, swz = sb ^ (((sb >> 9) & 1) << 5); R = (st >> 1) * 16 + swz / 64; C = (st & 1) * 32 + (swz % 64) / 2; }
__host__ __device__ __forceinline__ int perm32(int rho) { const int n = rho >> 4, i = rho & 15; return 8 * (i >> 2) + 4 * n + (i & 3); }

struct Unit { int pm, pn; };
struct Gemm { const bf16_t* A; const bf16_t* Bt; int M, N, K; };

struct StaticOrder {
    int nM, nN, nwg, G, c;
    __host__ __device__ void init(int M, int N, int G_, int c_) { nM = M / BM; nN = N / BM; nwg = nM * nN; G = G_; c = c_; }
    __host__ __device__ bool next(int i, Unit& u) const {
        const long L = (long)i * G + c; if (L >= nwg) return false;
        int wgid = (int)L; { const int q = nwg / NXCD, r = nwg % NXCD, xcd = wgid % NXCD, off = wgid / NXCD; wgid = (xcd < r ? xcd * (q + 1) : r * (q + 1) + (xcd - r) * q) + off; }
        const int nig = WGM * nN, gid = wgid / nig, fm = gid * WGM, gsz = (nM - fm) < WGM ? (nM - fm) : WGM;
        u.pm = fm + ((wgid % nig) % gsz); u.pn = (wgid % nig) / gsz; return true;
    }
    __device__ __forceinline__ void a_ready(const Unit&) const {}
    __device__ __forceinline__ void done(const Unit&) const {}
};

__device__ __forceinline__ unsigned cvt_pk_bf16(float lo, float hi) { unsigned r; asm volatile("v_cvt_pk_bf16_f32 %0, %1, %2" : "=v"(r) : "v"(lo), "v"(hi)); return r; }
typedef float f32x2 __attribute__((ext_vector_type(2)));
__device__ __forceinline__ f32x2 gelu_pk(f32x2 v) {
    const f32x2 av = __builtin_elementwise_abs(v), d = av * 0.2316418882f + 1.0f;
    f32x2 t; t.x = __builtin_amdgcn_rcpf(d.x); t.y = __builtin_amdgcn_rcpf(d.y);
    f32x2 q = t * 0.5307027145f + (-0.7265760135f); q = q * t + 0.7107068705f; q = q * t + (-0.142248368f); q = q * t + 0.127414796f; q = q * t;
    const f32x2 s = (v * v) * (-0.72134752044f);
    f32x2 e; e.x = __builtin_amdgcn_exp2f(s.x); e.y = __builtin_amdgcn_exp2f(s.y);
    const f32x2 m = v * (q * e), r = v - m;
    f32x2 o; o.x = v.x < 0.f ? m.x : r.x; o.y = v.y < 0.f ? m.y : r.y; return o;
}

template <int ACT  > struct EpiBf16 {
    static constexpr bool PERM = true, AFTER_DRAIN = false; static_assert(ACT == 0 || ACT == 1, "EpiBf16: ACT is 0 (none) or 1 (gelu_pk)");
    bf16_t* O; int ldc; const float* bias; int split_cols; size_t split_stride; float scale0;
    __device__ __forceinline__ void operator()(const f32x4 (&acc)[2][2][4][2], const Unit& u, int wr, int wc, int fr, int fq) const {
        const int row0 = u.pm * BM + wr * 64 + fr; int colt = u.pn * BM; bf16_t* base = O;
        float sc = 1.f; if (split_cols) { const int t = colt / split_cols; base += (size_t)t * split_stride; colt -= t * split_cols; if (t == 0) sc = scale0; }
        const int col0 = colt + wc * 32 + 8 * fq, bcol0 = u.pn * BM + wc * 32 + 8 * fq;
        f32x4 bv[2][2];
#pragma unroll
        for (int bj = 0; bj < 2; ++bj)
#pragma unroll
            for (int n = 0; n < 2; ++n) bv[bj][n] = bias ? *(const f32x4*)(bias + bcol0 + bj * HALF + 4 * n) : (f32x4){0.f, 0.f, 0.f, 0.f};
#pragma unroll
        for (int ai = 0; ai < 2; ++ai)
#pragma unroll
            for (int m = 0; m < 4; ++m) { bf16_t* rowp = base + (size_t)(row0 + ai * HALF + m * 16) * ldc + col0;
#pragma unroll
                for (int bj = 0; bj < 2; ++bj) { f32x4 v0 = acc[ai][bj][m][0] + bv[bj][0], v1 = acc[ai][bj][m][1] + bv[bj][1];
                    if (ACT == 1) { f32x2 a = gelu_pk((f32x2){v0[0], v0[1]}), b = gelu_pk((f32x2){v0[2], v0[3]}), c = gelu_pk((f32x2){v1[0], v1[1]}), d = gelu_pk((f32x2){v1[2], v1[3]});
                        v0 = (f32x4){a.x, a.y, b.x, b.y}; v1 = (f32x4){c.x, c.y, d.x, d.y}; }
                    v0 = v0 * sc; v1 = v1 * sc; u32x4 w; w.x = cvt_pk_bf16(v0[0], v0[1]); w.y = cvt_pk_bf16(v0[2], v0[3]); w.z = cvt_pk_bf16(v1[0], v1[1]); w.w = cvt_pk_bf16(v1[2], v1[3]);
                    *(u32x4*)(rowp + bj * HALF) = w; } }
    }
};
struct EpiProj {
    static constexpr bool PERM = true, AFTER_DRAIN = false;
    bf16_t* O; int ldc;
    __device__ __forceinline__ void operator()(const f32x4 (&acc)[2][2][4][2], const Unit& u, int wr, int wc, int fr, int fq) const {
        const int row0 = u.pm * BM + wr * 64 + fr; const int col0 = u.pn * BM + wc * 32 + 8 * fq;
        const float sc = (u.pn < 4 || u.pn == 18 || u.pn == 19) ? 0.08838834764831845f : 1.0f;
#pragma unroll
        for (int ai = 0; ai < 2; ++ai)
#pragma unroll
            for (int m = 0; m < 4; ++m) { bf16_t* rowp = O + (size_t)(row0 + ai * HALF + m * 16) * ldc + col0;
#pragma unroll
                for (int bj = 0; bj < 2; ++bj) { f32x4 v0 = acc[ai][bj][m][0] * sc, v1 = acc[ai][bj][m][1] * sc;
                    u32x4 w; w.x = cvt_pk_bf16(v0[0], v0[1]); w.y = cvt_pk_bf16(v0[2], v0[3]); w.z = cvt_pk_bf16(v1[0], v1[1]); w.w = cvt_pk_bf16(v1[2], v1[3]);
                    *(u32x4*)(rowp + bj * HALF) = w; } }
    }
};
struct EpiResid {
    static constexpr bool PERM = false, AFTER_DRAIN = false;
    const float* base; float* out; const float* gate; int ldc, rows_per_batch, gate_stride;
    __device__ __forceinline__ void operator()(const f32x4 (&acc)[2][2][4][2], const Unit& u, int wr, int wc, int fr, int fq) const {
        const int col0 = u.pn * BM + wc * 32 + 4 * fq; const int b = (u.pm * BM) / rows_per_batch;
        f32x4 gv[2][2];
#pragma unroll
        for (int bj = 0; bj < 2; ++bj)
#pragma unroll
            for (int n = 0; n < 2; ++n) gv[bj][n] = *(const f32x4*)(gate + (size_t)b * gate_stride + col0 + bj * HALF + n * 16);
#pragma unroll
        for (int ai = 0; ai < 2; ++ai)
#pragma unroll
            for (int m = 0; m < 4; ++m) { const size_t off = (size_t)(u.pm * BM + ai * HALF + wr * 64 + m * 16 + fr) * ldc + col0;
#pragma unroll
                for (int bj = 0; bj < 2; ++bj)
#pragma unroll
                    for (int n = 0; n < 2; ++n) { const f32x4 bs = *(const f32x4*)(base + off + bj * HALF + n * 16);
                        *(f32x4*)(out + off + bj * HALF + n * 16) = bs + gv[bj][n] * acc[ai][bj][m][n]; } }
    }
};
template <class Epi, class Sched, bool ALIGN_EPI = false, bool SP2 = false>
__device__ __forceinline__ void gemm_phase(PG8_LAS unsigned char* lds, const Gemm g, const Sched& S, const Epi& E) {
    int tid_l = threadIdx.x; asm volatile("" : "+v"(tid_l));
    const int tid = tid_l, wid = __builtin_amdgcn_readfirstlane(tid >> 6), lane = tid & 63, wr = wid >> 2, wc = wid & 3, fr = lane & 15, fq = lane >> 4;
    const int K = g.K, nt = K / BK;
    unsigned voffA[2], voffB[2];
#pragma unroll
    for (int i = 0; i < 2; ++i) { int R, C; stage_rc(tid * 16 + i * 8192, R, C); const int Rb = Epi::PERM ? ((R & ~31) + perm32(R & 31)) : R;
        voffA[i] = (unsigned)(R * K + C) * 2u; voffB[i] = (unsigned)(Rb * K + C) * 2u; }
    const size_t kstep = (size_t)(BK * 2);
    const size_t hstep = (size_t)HALF * K * 2;
    const size_t tstep = 2 * hstep;
    const unsigned ldsw = (unsigned)wid * 1024u;
    const int aoff = lds_byte(wr * 64 + fr, fq * 8), boff = lds_byte(wc * 32 + fr, fq * 8);
#define PG8_SA(b, h) (((b) * 2 + (h)) * HTB)
#define PG8_SB(b, h) ((4 + (b) * 2 + (h)) * HTB)
#define PG8_STAGE(bufoff, gbase, voff) do { _Pragma("unroll") for (int _i = 0; _i < 2; ++_i) \
        __builtin_amdgcn_global_load_lds((const unsigned*)((const char*)(gbase) + (voff)[_i]), (PG8_LAS unsigned*)(lds + (bufoff) + ldsw + _i * 8192), 16, 0, 0); } while (0)
#define PG8_LDA(dst, b, h) do { _Pragma("unroll") for (int m = 0; m < 4; ++m) _Pragma("unroll") for (int k = 0; k < 2; ++k) dst[m][k] = *(const PG8_LAS bf16x8*)(lds + PG8_SA(b, h) + aoff + m * 2048 + k * 1024); } while (0)
#define PG8_LDB(dst, b, h) do { _Pragma("unroll") for (int n = 0; n < 2; ++n) _Pragma("unroll") for (int k = 0; k < 2; ++k) dst[n][k] = *(const PG8_LAS bf16x8*)(lds + PG8_SB(b, h) + boff + n * 2048 + k * 1024); } while (0)
#define PG8_MMA(ai, bj, At, Bt) do { __builtin_amdgcn_s_setprio(1); _Pragma("unroll") for (int m = 0; m < 4; ++m) _Pragma("unroll") for (int n = 0; n < 2; ++n) _Pragma("unroll") for (int k = 0; k < 2; ++k) \
        acc[ai][bj][m][n] = __builtin_amdgcn_mfma_f32_16x16x32_bf16(Bt[n][k], At[m][k], acc[ai][bj][m][n], 0, 0, 0); __builtin_amdgcn_s_setprio(0); } while (0)
#define PG8_WAIT_V(n) asm volatile("s_waitcnt vmcnt(" #n ")" ::: "memory")
#define PG8_WAIT_L(n) asm volatile("s_waitcnt lgkmcnt(" #n ")" ::: "memory")
#define PG8_BAR __builtin_amdgcn_s_barrier()
#define PG8_SCHED __builtin_amdgcn_sched_barrier(0)
    Unit cur, nxt; int ui = 0;
    if (!S.next(0, cur)) return;
    f32x4 acc[2][2][4][2];
#pragma unroll
    for (int a = 0; a < 2; ++a)
#pragma unroll
        for (int b = 0; b < 2; ++b)
#pragma unroll
            for (int m = 0; m < 4; ++m)
#pragma unroll
                for (int n = 0; n < 2; ++n) acc[a][b][m][n] = (f32x4){0.f, 0.f, 0.f, 0.f};
    bf16x8 At[4][2], B0[2][2], B1[2][2];
    const char* cA = (const char*)g.A + (size_t)cur.pm * tstep; const char* cB = (const char*)g.Bt + (size_t)cur.pn * tstep;
    S.a_ready(cur);
    if constexpr (SP2) {
        PG8_STAGE(PG8_SB(0, 0), cB, voffB); PG8_STAGE(PG8_SB(0, 1), cB + hstep, voffB); PG8_STAGE(PG8_SA(0, 0), cA, voffA); PG8_STAGE(PG8_SA(0, 1), cA + hstep, voffA);
        if (wr == 1) PG8_BAR;
        PG8_WAIT_V(2); PG8_BAR;
        PG8_STAGE(PG8_SB(1, 0), cB + kstep, voffB); PG8_STAGE(PG8_SA(1, 0), cA + kstep, voffA); PG8_STAGE(PG8_SB(1, 1), cB + hstep + kstep, voffB);
        PG8_WAIT_V(6); PG8_BAR;
    } else {
        PG8_STAGE(PG8_SB(0, 0), cB, voffB); PG8_STAGE(PG8_SA(0, 0), cA, voffA); PG8_STAGE(PG8_SB(0, 1), cB + hstep, voffB); PG8_STAGE(PG8_SA(0, 1), cA + hstep, voffA);
        if (wr == 1) PG8_BAR;
        PG8_WAIT_V(4); PG8_BAR;
        PG8_STAGE(PG8_SB(1, 0), cB + kstep, voffB); PG8_STAGE(PG8_SA(1, 0), cA + kstep, voffA); PG8_STAGE(PG8_SB(1, 1), cB + hstep + kstep, voffB);
        PG8_WAIT_V(6); PG8_BAR;
    }
    for (;;) {
        const bool has_next = S.next(ui + 1, nxt);
        const char* nA = has_next ? (const char*)g.A + (size_t)nxt.pm * tstep : cA; const char* nB = has_next ? (const char*)g.Bt + (size_t)nxt.pn * tstep : cB;
        for (int t = 0; t < nt; t += 2) {
            const bool last = (t == nt - 2);
            const char* a1 = cA + (size_t)(t + 1) * kstep;
            const char* a2 = last ? nA : cA + (size_t)(t + 2) * kstep; const char* b2 = last ? nB : cB + (size_t)(t + 2) * kstep;
            const char* a3 = a2 + kstep; const char* b3 = b2 + kstep;
            if (last && has_next) S.a_ready(nxt);
            if constexpr (SP2) {
            PG8_LDB(B0, 0, 0); PG8_LDB(B1, 0, 1); PG8_SCHED; PG8_LDA(At, 0, 0); PG8_STAGE(PG8_SA(1, 1), a1 + hstep, voffA);
            PG8_WAIT_V(8); PG8_WAIT_L(0); PG8_BAR; PG8_MMA(0, 0, At, B0); PG8_MMA(0, 1, At, B1); PG8_BAR; PG8_SCHED;
            PG8_LDA(At, 0, 1); PG8_STAGE(PG8_SB(0, 0), b2, voffB); PG8_STAGE(PG8_SB(0, 1), b2 + hstep, voffB); PG8_STAGE(PG8_SA(0, 0), a2, voffA);
            PG8_WAIT_V(8); PG8_WAIT_L(0); PG8_BAR; PG8_MMA(1, 0, At, B0); PG8_MMA(1, 1, At, B1); PG8_BAR; PG8_SCHED;
            PG8_LDB(B0, 1, 0); PG8_LDB(B1, 1, 1); PG8_SCHED; PG8_LDA(At, 1, 0); PG8_STAGE(PG8_SA(0, 1), a2 + hstep, voffA);
            PG8_WAIT_V(8); PG8_WAIT_L(0); PG8_BAR; PG8_MMA(0, 0, At, B0); PG8_MMA(0, 1, At, B1); PG8_BAR; PG8_SCHED;
            PG8_LDA(At, 1, 1); PG8_STAGE(PG8_SB(1, 0), b3, voffB); PG8_STAGE(PG8_SB(1, 1), b3 + hstep, voffB); PG8_STAGE(PG8_SA(1, 0), a3, voffA);
            PG8_WAIT_V(8); PG8_WAIT_L(0); PG8_BAR; PG8_MMA(1, 0, At, B0); PG8_MMA(1, 1, At, B1); PG8_BAR; PG8_SCHED;
            } else {
            PG8_LDB(B0, 0, 0); PG8_SCHED; PG8_LDA(At, 0, 0); PG8_STAGE(PG8_SA(1, 1), a1 + hstep, voffA);
            PG8_WAIT_L(8); PG8_BAR; PG8_WAIT_L(0); PG8_MMA(0, 0, At, B0); PG8_BAR; PG8_SCHED;
            PG8_LDB(B1, 0, 1); PG8_STAGE(PG8_SB(0, 0), b2, voffB);
            PG8_BAR; PG8_WAIT_L(0); PG8_MMA(0, 1, At, B1); PG8_BAR;
            PG8_LDA(At, 0, 1); PG8_STAGE(PG8_SA(0, 0), a2, voffA);
            PG8_BAR; PG8_WAIT_L(0); PG8_MMA(1, 0, At, B0); PG8_BAR; PG8_SCHED;
            PG8_STAGE(PG8_SB(0, 1), b2 + hstep, voffB);
            PG8_WAIT_V(6); PG8_BAR; PG8_MMA(1, 1, At, B1); PG8_BAR;
            PG8_LDB(B0, 1, 0); PG8_SCHED; PG8_LDA(At, 1, 0); PG8_STAGE(PG8_SA(0, 1), a2 + hstep, voffA);
            PG8_WAIT_L(8); PG8_BAR; PG8_WAIT_L(0); PG8_MMA(0, 0, At, B0); PG8_BAR; PG8_SCHED;
            PG8_LDB(B1, 1, 1); PG8_STAGE(PG8_SB(1, 0), b3, voffB);
            PG8_BAR; PG8_WAIT_L(0); PG8_MMA(0, 1, At, B1); PG8_BAR;
            PG8_LDA(At, 1, 1); PG8_STAGE(PG8_SA(1, 0), a3, voffA);
            PG8_BAR; PG8_WAIT_L(0); PG8_MMA(1, 0, At, B0); PG8_BAR; PG8_SCHED;
            PG8_STAGE(PG8_SB(1, 1), b3 + hstep, voffB);
            PG8_WAIT_V(6); PG8_BAR; PG8_MMA(1, 1, At, B1); PG8_BAR;
            }
        }
        if constexpr (ALIGN_EPI) { if (wr == 0) PG8_BAR; }
        if constexpr (!Epi::AFTER_DRAIN) { E(acc, cur, wr, wc, fr, fq); S.done(cur); }
        if (!has_next) break;
#pragma unroll
        for (int a = 0; a < 2; ++a)
#pragma unroll
            for (int b = 0; b < 2; ++b)
#pragma unroll
                for (int m = 0; m < 4; ++m)
#pragma unroll
                    for (int n = 0; n < 2; ++n) acc[a][b][m][n] = (f32x4){0.f, 0.f, 0.f, 0.f};
        cur = nxt; cA = nA; cB = nB; ++ui;
        if constexpr (ALIGN_EPI) { if (wr == 1) PG8_BAR; }
    }
    PG8_WAIT_V(0);
    if constexpr (!ALIGN_EPI) { if (wr == 0) PG8_BAR; }
    PG8_BAR;
    if constexpr (Epi::AFTER_DRAIN) { E.fused(acc, cur, wr, wc, fr, fq, lds, wid, lane); S.done(cur); }
#undef PG8_SA
#undef PG8_SB
#undef PG8_STAGE
#undef PG8_LDA
#undef PG8_LDB
#undef PG8_MMA
#undef PG8_WAIT_V
#undef PG8_WAIT_L
#undef PG8_BAR
#undef PG8_SCHED
}
}
#define GAS __attribute__((address_space(1)))
#define LAS __attribute__((address_space(3)))
typedef unsigned short bf16;
typedef unsigned v4u __attribute__((ext_vector_type(4)));
typedef float f32x4 __attribute__((ext_vector_type(4)));
typedef short bf16x8 __attribute__((ext_vector_type(8)));
typedef GAS unsigned gu32;
typedef GAS unsigned long long gu64;
#define RLX_AGENT __ATOMIC_RELAXED, __HIP_MEMORY_SCOPE_AGENT
#define LDS_WAIT() asm volatile("s_waitcnt lgkmcnt(0)" ::: "memory")
#define VM_WAIT() asm volatile("s_waitcnt vmcnt(0)" ::: "memory")
__device__ __forceinline__ unsigned long long rt() { return __builtin_amdgcn_s_memrealtime(); }
__device__ __forceinline__ unsigned f2bf(float f) { unsigned u = __builtin_bit_cast(unsigned, f); return (u + 0x7fffu + ((u >> 16) & 1u)) >> 16; }
__device__ __forceinline__ unsigned pk2(float lo, float hi) { return f2bf(lo) | (f2bf(hi) << 16); }

#define XB_TMO      128
#define XB_XCNT(j)  (256  + 64 * (j))
#define XB_XSUB(j)  (1280 + 64 * (j))
#define XB_XGEN(j)  (2304 + 64 * (j))
#define XB_TOP      3328
#define XB_TOPGEN   3392
#define XCD_BAR_WORDS 3456
#define XB_SPIN_CAP (1u << 18)

__device__ __forceinline__ unsigned xb_ld(unsigned* p)              { return __hip_atomic_load(p, __ATOMIC_RELAXED, __HIP_MEMORY_SCOPE_AGENT); }
__device__ __forceinline__ unsigned xb_add(unsigned* p, unsigned v) { return __hip_atomic_fetch_add(p, v, __ATOMIC_RELAXED, __HIP_MEMORY_SCOPE_AGENT); }
__device__ __forceinline__ unsigned xb_xcc_id() { return (unsigned)__builtin_amdgcn_s_getreg((3 << 11) | 20) & 0xFu; }
#define XB_SPIN(cond, bar) do { unsigned _sp = 0; while (cond) { __builtin_amdgcn_s_sleep(1); \
    if ((++_sp & 255u) == 0u) { if (xb_ld(&(bar)[XB_TMO])) break; if (_sp > XB_SPIN_CAP) { atomicAdd(&(bar)[XB_TMO], 1u); break; } } } } while (0)

struct XcdBarrier {
    unsigned* bar; unsigned x;
    volatile LAS unsigned* st;
};

__device__ __forceinline__ XcdBarrier xcd_barrier_post(unsigned* bar, volatile LAS unsigned* st) {
    XcdBarrier b; b.bar = bar; b.x = xb_xcc_id(); b.st = st;
    if (threadIdx.x == 0) (void)xb_add(&bar[XB_XCNT(b.x)], 1u);
    return b;
}
__device__ __forceinline__ void xcd_barrier_complete(unsigned* bar, unsigned x, unsigned& nloc, unsigned& nx) {
    const unsigned G = gridDim.x * gridDim.y * gridDim.z;
    unsigned sum, cnt, mine, sp = 0u;
    for (;;) {
        sum = 0u; cnt = 0u; mine = 0u;
#pragma unroll
        for (unsigned j = 0; j < 16; ++j) { const unsigned c = xb_ld(&bar[XB_XCNT(j)]); sum += c; cnt += (c > 0u) ? 1u : 0u; mine = (j == x) ? c : mine; }
        if (sum == G) break;
        __builtin_amdgcn_s_sleep(1);
        if ((++sp & 255u) == 0u) { if (xb_ld(&bar[XB_TMO])) break; if (sp > XB_SPIN_CAP) { atomicAdd(&bar[XB_TMO], 1u); break; } }
    }
    nloc = mine > 0u ? mine : 1u; nx = cnt > 0u ? cnt : 1u;
}

__device__ __forceinline__ void xcd_barrier(const XcdBarrier& b) {
    asm volatile("s_waitcnt vmcnt(0)" ::: "memory");
    __syncthreads();
    if (threadIdx.x == 0) {
        unsigned* bar = b.bar;
        __builtin_amdgcn_s_waitcnt(0);
        unsigned nloc = b.st[0], nx = b.st[1];
        if (nloc == 0u) { xcd_barrier_complete(bar, b.x, nloc, nx); b.st[0] = nloc; b.st[1] = nx; }
        const unsigned old = xb_add(&bar[XB_XSUB(b.x)], 1u);
        const unsigned gen = old / nloc;
        if (old + 1u == (gen + 1u) * nloc) {
            __builtin_amdgcn_fence(__ATOMIC_RELEASE, "agent");
            asm volatile("s_waitcnt vmcnt(0)" ::: "memory");
            const unsigned og = xb_add(&bar[XB_TOP], 1u);
            const unsigned tg = og / nx;
            if (og + 1u == (tg + 1u) * nx) xb_add(&bar[XB_TOPGEN], 1u);
            else XB_SPIN(xb_ld(&bar[XB_TOPGEN]) == tg, bar);
            __builtin_amdgcn_fence(__ATOMIC_ACQUIRE, "agent");
            xb_add(&bar[XB_XGEN(b.x)], 1u);
            asm volatile("s_waitcnt vmcnt(0)" ::: "memory");
        } else {
            XB_SPIN(xb_ld(&bar[XB_XGEN(b.x)]) == gen, bar);
            __builtin_amdgcn_fence(__ATOMIC_ACQUIRE, "agent");
            asm volatile("s_waitcnt vmcnt(0)" ::: "memory");
        }
    }
    __syncthreads();
}
constexpr int NWAVES = 8;
constexpr int NB = 2, SEQ = 4096, M = NB * SEQ, D = 2048, NP = 7168, DEPTH = 4, MODW = 3 * D;
constexpr int C_QA = 0, C_KA = 1024, C_VA = 2048, C_ZA = 3072, C_QR = 4096, C_KR = 4608, C_VR = 5120, C_ZR = 6144;
constexpr float EPS = 1e-6f;
#ifndef ONE_LAUNCH
#define ONE_LAUNCH 1
#endif
#ifndef NAIVE_ATT
#define NAIVE_ATT 1
#endif
#ifndef NAIVE_RET
#define NAIVE_RET 1
#endif
constexpr size_t MiB = 1u << 20;
constexpr size_t WS_CTL = 0, CTL_ZERO_BYTES = 64 * 1024;
constexpr size_t WS_MOD = 1 * MiB;
constexpr size_t WS_WIN = 2 * MiB;
constexpr size_t WS_WOUT = 114 * MiB;
constexpr size_t WS_HN = 146 * MiB;
constexpr size_t WS_PROJ = 178 * MiB;
constexpr size_t WS_Y = 290 * MiB;
constexpr size_t WS_X = 322 * MiB;
constexpr size_t WS_RET = 386 * MiB;
constexpr size_t WS_END = 482 * MiB;
constexpr int CW_BAR = 1024;
static_assert((CW_BAR + XCD_BAR_WORDS) * 4 <= (int)CTL_ZERO_BYTES, "CTL");
constexpr int RING_BYTES = 131072, MISC_OFF = RING_BYTES + 320, LDS_BYTES = 147456;

__device__ __forceinline__ float bf2f(unsigned u) { return __uint_as_float(u << 16); }
__device__ __forceinline__ float silu_f(float v) { return v / (1.0f + __expf(-v)); }
__device__ __forceinline__ float wave_sum(float v) {
#pragma unroll
    for (int o = 1; o < 64; o <<= 1) v += __shfl_xor(v, o);
    return v;
}
__device__ __forceinline__ float wave_max(float v) {
#pragma unroll
    for (int o = 1; o < 64; o <<= 1) v = fmaxf(v, __shfl_xor(v, o));
    return v;
}

__device__ __forceinline__ void p0_gemv(const float* c, const float* w_ada, const float* b_ada, float* MOD, LAS unsigned char* lds, int g, int tid) {
    const int wave = tid >> 6, lane = tid & 63, rs = lane >> 3, cgp = lane & 7;
    const int l = g >> 6, col0 = (g & 63) * 96;
    const float* W = w_ada + (size_t)l * D * MODW + col0 + cgp * 12;
    float a0[12], a1[12];
#pragma unroll
    for (int j = 0; j < 12; ++j) { a0[j] = 0.f; a1[j] = 0.f; }
#pragma unroll 4
    for (int it = 0; it < 32; ++it) {
        const int k = wave * 256 + it * 8 + rs;
        const float s0 = silu_f(c[k]), s1 = silu_f(c[D + k]);
        const f32x4* wp = (const f32x4*)(W + (size_t)k * MODW);
        const f32x4 w0 = wp[0], w1 = wp[1], w2 = wp[2];
#pragma unroll
        for (int j = 0; j < 4; ++j) { a0[j] += s0 * w0[j]; a0[4 + j] += s0 * w1[j]; a0[8 + j] += s0 * w2[j]; a1[j] += s1 * w0[j]; a1[4 + j] += s1 * w1[j]; a1[8 + j] += s1 * w2[j]; }
    }
#pragma unroll
    for (int j = 0; j < 12; ++j) {
        a0[j] += __shfl_xor(a0[j], 8); a0[j] += __shfl_xor(a0[j], 16); a0[j] += __shfl_xor(a0[j], 32);
        a1[j] += __shfl_xor(a1[j], 8); a1[j] += __shfl_xor(a1[j], 16); a1[j] += __shfl_xor(a1[j], 32);
    }
    LAS float* red = (LAS float*)lds;
    if (rs == 0) {
#pragma unroll
        for (int j = 0; j < 12; ++j) { red[(wave * 2 + 0) * 96 + cgp * 12 + j] = a0[j]; red[(wave * 2 + 1) * 96 + cgp * 12 + j] = a1[j]; }
    }
    __syncthreads();
    if (tid < 192) { const int b = tid / 96, j = tid % 96; float s = b_ada[l * MODW + col0 + j];
#pragma unroll
        for (int w = 0; w < 8; ++w) s += red[(w * 2 + b) * 96 + j];
        MOD[(size_t)(l * 2 + b) * MODW + col0 + j] = s; }
    __syncthreads();
}
__device__ __forceinline__ void p0_transpose_item(const float* W, int K, int N, bf16* WT, LAS float* scr, int item, int lane) {
    const int nblk = N / 32, kb = item / nblk, nb = item % nblk, k0 = 64 * kb, n0 = 32 * nb;
#pragma unroll 8
    for (int i = 0; i < 32; ++i) { const int kk = 2 * i + (lane >> 5); scr[kk * 33 + (lane & 31)] = W[(size_t)(k0 + kk) * N + n0 + (lane & 31)]; }
    LDS_WAIT(); asm volatile("" ::: "memory");
    const int c = lane & 7;
#pragma unroll
    for (int j = 0; j < 4; ++j) { const int n = (lane >> 3) + 8 * j; const LAS float* s = scr + (8 * c) * 33 + n;
        v4u o; o.x = pk2(s[0 * 33], s[1 * 33]); o.y = pk2(s[2 * 33], s[3 * 33]); o.z = pk2(s[4 * 33], s[5 * 33]); o.w = pk2(s[6 * 33], s[7 * 33]);
        *(GAS v4u*)(WT + (size_t)(n0 + n) * K + k0 + 8 * c) = o; }
    LDS_WAIT(); asm volatile("" ::: "memory");
}
__device__ __forceinline__ void p0_transposes(const float* w_in, const float* w_out, bf16* WIN_T, bf16* WOUT_T, LAS unsigned char* lds, int gw, int NGW, int wave, int lane) {
    LAS float* scr = (LAS float*)(lds + wave * 16384);
    constexpr int I_IN = (D / 64) * (NP / 32), I_OUT = (D / 64) * (D / 32), I_L = I_IN + I_OUT;
    for (int it = gw; it < DEPTH * I_L; it += NGW) {
        const int l = it / I_L; int r = it % I_L;
        if (r < I_IN) p0_transpose_item(w_in + (size_t)l * D * NP, D, NP, WIN_T + (size_t)l * NP * D, scr, r, lane);
        else p0_transpose_item(w_out + (size_t)l * D * D, D, D, WOUT_T + (size_t)l * D * D, scr, r - I_IN, lane);
    }
}

template <bool FINAL>
__device__ __forceinline__ void norm_rows(const float* src, const float* gain, const float* mod, bf16* outb, float* outf, int gw, int NGW, int lane) {
    for (int m = gw; m < M; m += NGW) {
        const f32x4* xr = (const f32x4*)(src + (size_t)m * D) + lane;
        f32x4 v[8]; float ss = 0.f;
#pragma unroll
        for (int j = 0; j < 8; ++j) { v[j] = xr[64 * j]; ss += (v[j].x * v[j].x + v[j].y * v[j].y) + (v[j].z * v[j].z + v[j].w * v[j].w); }
        const float rstd = rsqrtf(wave_sum(ss) * (1.0f / D) + EPS);
        const int b = m / SEQ;
#pragma unroll
        for (int j = 0; j < 8; ++j) {
            const int col = 4 * (lane + 64 * j);
            const f32x4 g4 = *(const f32x4*)(gain + col);
            f32x4 y = v[j] * rstd * g4;
            if constexpr (FINAL) { *(f32x4*)(outf + (size_t)m * D + col) = y; }
            else {
                const f32x4 sh = *(const f32x4*)(mod + (size_t)b * MODW + col), sc = *(const f32x4*)(mod + (size_t)b * MODW + D + col);
                y = y * (sc + 1.0f) + sh;
                *(unsigned long long*)(outb + (size_t)m * D + col) = (unsigned long long)pk2(y.x, y.y) | ((unsigned long long)pk2(y.z, y.w) << 32);
            }
        }
    }
}

__device__ __forceinline__ void attn_naive(const bf16* PROJ, bf16* Y, LAS unsigned char* lds, int gw, int NGW, int wave, int lane) {
    LAS float* qs = (LAS float*)(lds + wave * 4096);
    LAS float* ps = qs + 128;
    for (int item = gw; item < M * 8; item += NGW) {
        const int m = item >> 3, h = item & 7, b = m / SEQ, t = m % SEQ;
        const float slope = exp2f(-(float)(h + 1));
        { const unsigned qq = *(const unsigned*)(PROJ + (size_t)m * NP + C_QA + h * 128 + 2 * lane); qs[2 * lane] = bf2f(qq & 0xffffu); qs[2 * lane + 1] = bf2f(qq >> 16); }
        LDS_WAIT(); asm volatile("" ::: "memory");
        float sc[7]; float mx = -1e30f;
#pragma unroll
        for (int r = 0; r < 7; ++r) {
            const int i = lane + 64 * r; const int p = i / 129, j = i % 129 - 64; const int dil = (p == 0) ? 1 : ((p == 1) ? 4 : 16);
            const int off = j * dil, s = t + off; const bool valid = (i < 387) && (s >= 0) && (s < SEQ);
            float dot = 0.f;
            if (valid) {
                const bf16* kr = PROJ + (size_t)(b * SEQ + s) * NP + C_KA + h * 128;
#pragma unroll 4
                for (int c8 = 0; c8 < 16; ++c8) { const v4u kk = *(const v4u*)(kr + 8 * c8); const f32x4 q0 = *(const LAS f32x4*)(qs + 8 * c8), q1 = *(const LAS f32x4*)(qs + 8 * c8 + 4);
                    dot += q0.x * bf2f(kk.x & 0xffffu) + q0.y * bf2f(kk.x >> 16) + q0.z * bf2f(kk.y & 0xffffu) + q0.w * bf2f(kk.y >> 16)
                         + q1.x * bf2f(kk.z & 0xffffu) + q1.y * bf2f(kk.z >> 16) + q1.z * bf2f(kk.w & 0xffffu) + q1.w * bf2f(kk.w >> 16); }
            }
            sc[r] = valid ? dot - slope * fabsf((float)off) : -1e30f;
            mx = fmaxf(mx, sc[r]);
        }
        mx = wave_max(mx);
        float lsum = 0.f;
#pragma unroll
        for (int r = 0; r < 7; ++r) { const float pr = __expf(sc[r] - mx); lsum += pr; ps[lane + 64 * r] = pr; }
        lsum = wave_sum(lsum);
        LDS_WAIT(); asm volatile("" ::: "memory");
        float o0 = 0.f, o1 = 0.f;
        for (int p = 0; p < 3; ++p) { const int dil = (p == 0) ? 1 : ((p == 1) ? 4 : 16);
#pragma unroll 8
            for (int jj = 0; jj < 129; ++jj) { int s = t + (jj - 64) * dil; s = s < 0 ? 0 : (s >= SEQ ? SEQ - 1 : s);
                const float pv = ps[p * 129 + jj];
                const unsigned vv = *(const unsigned*)(PROJ + (size_t)(b * SEQ + s) * NP + C_VA + h * 128 + 2 * lane);
                o0 += pv * bf2f(vv & 0xffffu); o1 += pv * bf2f(vv >> 16); } }
        const unsigned zz = *(const unsigned*)(PROJ + (size_t)m * NP + C_ZA + h * 128 + 2 * lane);
        const float inv = 1.0f / lsum;
        *(unsigned*)(Y + (size_t)m * D + h * 128 + 2 * lane) = pk2(o0 * inv * silu_f(bf2f(zz & 0xffffu)), o1 * inv * silu_f(bf2f(zz >> 16)));
        LDS_WAIT(); asm volatile("" ::: "memory");
    }
}

typedef short v4i16_t __attribute__((ext_vector_type(4)));
__device__ __forceinline__ unsigned pkbf(float lo, float hi) { unsigned r; asm("v_cvt_pk_bf16_f32 %0, %1, %2" : "=v"(r) : "v"(lo), "v"(hi)); return r; }
template <int NQ, int Q0>
__device__ __forceinline__ void att_pair(const bf16* Kb, const bf16* Vb, int sbase, int d, int u0, float nslope_d, const bf16x8 (&qf)[2][4], f32x4 (&O)[2][8], float (&mrun)[2], float (&lrun)[2],
                                         const int (&qi)[2], LAS unsigned char* vbuf, int lane) {
    const int g = lane >> 4, li = lane & 15;
    bf16x8 kf[2][4];
#pragma unroll
    for (int tt = 0; tt < 2; ++tt) { int s = sbase + d * (u0 + 16 * tt + li); s = s < 0 ? 0 : (s >= SEQ ? SEQ - 1 : s);
#pragma unroll
        for (int ks = 0; ks < 4; ++ks) kf[tt][ks] = *(const bf16x8*)(Kb + (size_t)s * NP + 32 * ks + 8 * g); }
    v4u vr[8];
#pragma unroll
    for (int it = 0; it < 8; ++it) { int s = sbase + d * (u0 + 4 * it + g); s = s < 0 ? 0 : (s >= SEQ ? SEQ - 1 : s); vr[it] = *(const v4u*)(Vb + (size_t)s * NP + 8 * li); }
    f32x4 sacc[NQ][2];
#pragma unroll
    for (int q = 0; q < NQ; ++q)
#pragma unroll
        for (int tt = 0; tt < 2; ++tt) { sacc[q][tt] = (f32x4){0.f, 0.f, 0.f, 0.f};
#pragma unroll
            for (int ks = 0; ks < 4; ++ks) sacc[q][tt] = __builtin_amdgcn_mfma_f32_16x16x32_bf16(kf[tt][ks], qf[Q0 + q][ks], sacc[q][tt], 0, 0, 0); }
    bf16x8 pf[NQ];
#pragma unroll
    for (int q = 0; q < NQ; ++q) {
        float sv[8]; bool ok[8]; float mt = -1e30f;
#pragma unroll
        for (int tt = 0; tt < 2; ++tt)
#pragma unroll
            for (int rg = 0; rg < 4; ++rg) { const int u = u0 + 16 * tt + 4 * g + rg, s = sbase + d * u, j = u - qi[Q0 + q], aj = j < 0 ? -j : j;
                ok[4 * tt + rg] = (aj <= 64) && (s >= 0) && (s < SEQ); sv[4 * tt + rg] = sacc[q][tt][rg] + nslope_d * (float)aj;
                mt = fmaxf(mt, ok[4 * tt + rg] ? sv[4 * tt + rg] : -1e30f); }
        mt = fmaxf(mt, __shfl_xor(mt, 16)); mt = fmaxf(mt, __shfl_xor(mt, 32));
        const float mnew = fmaxf(mrun[Q0 + q], mt), alpha = __expf(mrun[Q0 + q] - mnew); mrun[Q0 + q] = mnew;
        float p[8], psum = 0.f;
#pragma unroll
        for (int e = 0; e < 8; ++e) { p[e] = ok[e] ? __expf(sv[e] - mnew) : 0.f; psum += p[e]; }
        lrun[Q0 + q] = lrun[Q0 + q] * alpha + psum;
#pragma unroll
        for (int dt = 0; dt < 8; ++dt) O[Q0 + q][dt] = O[Q0 + q][dt] * alpha;
        v4u pw; pw.x = pkbf(p[0], p[1]); pw.y = pkbf(p[2], p[3]); pw.z = pkbf(p[4], p[5]); pw.w = pkbf(p[6], p[7]);
        pf[q] = __builtin_bit_cast(bf16x8, pw);
    }
#pragma unroll
    for (int it = 0; it < 8; ++it) { const int row = 4 * it + g; *(LAS v4u*)(vbuf + row * 256 + ((((li >> 1) ^ (row & 7))) << 5) + ((li & 1) << 4)) = vr[it]; }
    const int qq = li >> 2, pp = li & 3;
#pragma unroll
    for (int dt = 0; dt < 8; ++dt) {
        const int r0 = 4 * g + qq, r1 = 16 + 4 * g + qq;
        const v4i16_t a0 = __builtin_amdgcn_ds_read_tr16_b64_v4i16((LAS v4i16_t*)(vbuf + r0 * 256 + ((dt ^ (r0 & 7)) << 5) + 8 * pp));
        const v4i16_t a1 = __builtin_amdgcn_ds_read_tr16_b64_v4i16((LAS v4i16_t*)(vbuf + r1 * 256 + ((dt ^ (r1 & 7)) << 5) + 8 * pp));
        bf16x8 af; af[0] = a0[0]; af[1] = a0[1]; af[2] = a0[2]; af[3] = a0[3]; af[4] = a1[0]; af[5] = a1[1]; af[6] = a1[2]; af[7] = a1[3];
#pragma unroll
        for (int q = 0; q < NQ; ++q) O[Q0 + q][dt] = __builtin_amdgcn_mfma_f32_16x16x32_bf16(af, pf[q], O[Q0 + q][dt], 0, 0, 0);
    }
}
__device__ __forceinline__ void attn_unit(const bf16* PROJ, bf16* Y, int unit, LAS unsigned char* vbuf, int wave, int lane) {
    const int blk = unit & 15, h = (unit >> 4) & 7, b = unit >> 7, T0 = blk * 256;
    const int g = lane >> 4, li = lane & 15;
    const bf16* Pb = PROJ + (size_t)b * SEQ * NP;
    const bf16* Kb = Pb + C_KA + h * 128; const bf16* Vb = Pb + C_VA + h * 128;
    const float slope = exp2f(-(float)(h + 1));
    int rq[2]; rq[0] = wave; rq[1] = wave + 8;
    bf16x8 qf[2][4]; f32x4 O[2][8]; float mrun[2], lrun[2];
#pragma unroll
    for (int q = 0; q < 2; ++q) { const int tq = T0 + 16 * li + rq[q];
#pragma unroll
        for (int ks = 0; ks < 4; ++ks) qf[q][ks] = *(const bf16x8*)(Pb + (size_t)tq * NP + C_QA + h * 128 + 32 * ks + 8 * g);
#pragma unroll
        for (int dt = 0; dt < 8; ++dt) O[q][dt] = (f32x4){0.f, 0.f, 0.f, 0.f};
        mrun[q] = -1e30f; lrun[q] = 0.f; }
    int qi[2];
    qi[0] = 16 * li + rq[0]; qi[1] = 16 * li + rq[1];
    for (int pi = 0; pi < 12; ++pi) { const int u0 = -64 + 32 * pi; if (T0 + u0 + 31 < 0 || T0 + u0 >= SEQ) continue;
        att_pair<2, 0>(Kb, Vb, T0, 1, u0, -slope, qf, O, mrun, lrun, qi, vbuf, lane); }
    qi[0] = 4 * li + (rq[0] >> 2); qi[1] = 4 * li + (rq[1] >> 2);
    { const int sb = T0 + (wave & 3);
      for (int pi = 0; pi < 6; ++pi) { const int u0 = -64 + 32 * pi; if (sb + 4 * (u0 + 31) < 0 || sb + 4 * u0 >= SEQ) continue;
          att_pair<2, 0>(Kb, Vb, sb, 4, u0, -4.0f * slope, qf, O, mrun, lrun, qi, vbuf, lane); } }
    qi[0] = li; qi[1] = li;
    for (int pi = 0; pi < 5; ++pi) { const int u0 = -64 + 32 * pi; const int sb = T0 + rq[0]; if (sb + 16 * (u0 + 31) < 0 || sb + 16 * u0 >= SEQ) continue;
        att_pair<1, 0>(Kb, Vb, sb, 16, u0, -16.0f * slope, qf, O, mrun, lrun, qi, vbuf, lane); }
    for (int pi = 0; pi < 5; ++pi) { const int u0 = -64 + 32 * pi; const int sb = T0 + rq[1]; if (sb + 16 * (u0 + 31) < 0 || sb + 16 * u0 >= SEQ) continue;
        att_pair<1, 1>(Kb, Vb, sb, 16, u0, -16.0f * slope, qf, O, mrun, lrun, qi, vbuf, lane); }
#pragma unroll
    for (int q = 0; q < 2; ++q) { float l = lrun[q]; l += __shfl_xor(l, 16); l += __shfl_xor(l, 32); const float inv = 1.0f / l;
        const size_t tok = (size_t)b * SEQ + T0 + 16 * li + rq[q];
#pragma unroll
        for (int dt = 0; dt < 8; ++dt) { const int col = h * 128 + 16 * dt + 4 * g;
            const unsigned long long zz = *(const unsigned long long*)(PROJ + tok * NP + C_ZA + col); const unsigned z0 = (unsigned)zz, z1 = (unsigned)(zz >> 32);
            const f32x4 o = O[q][dt] * inv;
            *(unsigned long long*)(Y + tok * D + col) = (unsigned long long)pk2(o[0] * silu_f(bf2f(z0 & 0xffffu)), o[1] * silu_f(bf2f(z0 >> 16)))
                | ((unsigned long long)pk2(o[2] * silu_f(bf2f(z1 & 0xffffu)), o[3] * silu_f(bf2f(z1 >> 16))) << 32); } }
}

constexpr int LDT = 136;
__device__ __forceinline__ float log2_gamma(float logit) { return -log1pf(__expf(-logit)) * 1.4426950408889634f; }
template <int NT, int KSTEPS>
__device__ __forceinline__ void mma_lds(f32x4 (&acc)[NT], const LAS bf16* A, int lda, int arow0, const LAS bf16* Bt, int ldb, int bcol0, int lane) {
    const int g = lane >> 4, li = lane & 15;
#pragma unroll
    for (int ks = 0; ks < KSTEPS; ++ks) { const bf16x8 a = *(const LAS bf16x8*)(A + (arow0 + li) * lda + 32 * ks + 8 * g);
#pragma unroll
        for (int nt = 0; nt < NT; ++nt) { const bf16x8 b = *(const LAS bf16x8*)(Bt + (bcol0 + 16 * nt + li) * ldb + 32 * ks + 8 * g); acc[nt] = __builtin_amdgcn_mfma_f32_16x16x32_bf16(a, b, acc[nt], 0, 0, 0); } }
}
template <int NCH  , bool SCALE>
__device__ __forceinline__ void stage_T(const bf16* src, LAS bf16* dst, int tid, float zs, float zb, float zm) {
    const int j = tid & 127, cg0 = tid >> 7;
    float sc = 1.f; if (SCALE) sc = exp2f(zs * (zb + zm * (float)j));
#pragma unroll
    for (int it = 0; it < NCH; ++it) { const int c = cg0 + 4 * it; const v4u w = *(const v4u*)(src + (size_t)j * NP + 8 * c);
        unsigned short e[8]; e[0] = w.x & 0xffffu; e[1] = w.x >> 16; e[2] = w.y & 0xffffu; e[3] = w.y >> 16; e[4] = w.z & 0xffffu; e[5] = w.z >> 16; e[6] = w.w & 0xffffu; e[7] = w.w >> 16;
#pragma unroll
        for (int q = 0; q < 8; ++q) dst[(8 * c + q) * LDT + j] = SCALE ? (bf16)f2bf(bf2f(e[q]) * sc) : (bf16)e[q]; }
}
template <int NROWS, bool SCALE>
__device__ __forceinline__ void stage_N(const bf16* src, int ld, LAS bf16* dst, int tid, float zs, float zb, float zm) {
#pragma unroll
    for (int it = 0; it < NROWS * 16 / 512; ++it) { const int idx = tid + 512 * it, row = idx >> 4, c = idx & 15; v4u w = *(const v4u*)(src + (size_t)row * ld + 8 * c);
        if (SCALE) { const float sc = exp2f(zs * (zb + zm * (float)row));
            w.x = pk2(bf2f(w.x & 0xffffu) * sc, bf2f(w.x >> 16) * sc); w.y = pk2(bf2f(w.y & 0xffffu) * sc, bf2f(w.y >> 16) * sc);
            w.z = pk2(bf2f(w.z & 0xffffu) * sc, bf2f(w.z >> 16) * sc); w.w = pk2(bf2f(w.w & 0xffffu) * sc, bf2f(w.w >> 16) * sc); }
        *(LAS v4u*)(dst + row * LDT + 8 * c) = w; }
}
__device__ __forceinline__ void ret_chunk_state(const bf16* PROJ, const float* dec_f, const float* dec_b, float* KV, LAS unsigned char* lds, int unit, int tid) {
    const int n = unit & 31, h = (unit >> 5) & 3, b = unit >> 7, lane = tid & 63, wave = __builtin_amdgcn_readfirstlane(tid >> 6), g = lane >> 4, li = lane & 15;
    LAS bf16* VT = (LAS bf16*)lds; LAS bf16* KT = VT + 256 * LDT;
    const bf16* rowp = PROJ + (size_t)(b * SEQ + n * 128) * NP;
    const float lf2 = log2_gamma(dec_f[h]), lb2 = log2_gamma(dec_b[h]);
    stage_T<8, false>(rowp + C_VR + h * 256, VT, tid, 0.f, 0.f, 0.f);
#pragma unroll 1
    for (int dir = 0; dir < 2; ++dir) {
        if (dir == 0) stage_T<4, true>(rowp + C_KR + h * 128, KT, tid, lf2, 127.f, -1.f);
        else          stage_T<4, true>(rowp + C_KR + h * 128, KT, tid, lb2, 0.f, 1.f);
        __syncthreads();
        f32x4 acc[16];
#pragma unroll
        for (int nt = 0; nt < 16; ++nt) acc[nt] = (f32x4){0.f, 0.f, 0.f, 0.f};
        mma_lds<16, 4>(acc, KT, LDT, 16 * wave, VT, LDT, 0, lane);
        float* out = KV + ((size_t)(((dir * 2 + b) * 4 + h) * 32 + n)) * 32768;
#pragma unroll
        for (int nt = 0; nt < 16; ++nt) *(f32x4*)(out + (16 * nt + li) * 128 + 16 * wave + 4 * g) = acc[nt];
        __syncthreads();
    }
}
__device__ __forceinline__ void ret_scan(const float* KV, bf16* Sbf, const float* dec_f, const float* dec_b, int gt) {
    const int seq = gt >> 13, e4 = gt & 8191, dir = seq >> 3, h = seq & 3;
    const float gch = exp2f(128.f * log2_gamma(dir ? dec_b[h] : dec_f[h]));
    const float* kv = KV + (size_t)seq * 32 * 32768 + 4 * e4; bf16* sb = Sbf + (size_t)seq * 32 * 32768 + 4 * e4;
    f32x4 S = (f32x4){0.f, 0.f, 0.f, 0.f};
#pragma unroll 1
    for (int n0 = 0; n0 < 32; n0 += 8) {
        f32x4 v[8];
#pragma unroll
        for (int i = 0; i < 8; ++i) { const int n = dir ? 31 - (n0 + i) : n0 + i; v[i] = *(const f32x4*)(kv + (size_t)n * 32768); }
#pragma unroll
        for (int i = 0; i < 8; ++i) { const int n = dir ? 31 - (n0 + i) : n0 + i;
            *(unsigned long long*)(sb + (size_t)n * 32768) = (unsigned long long)pk2(S.x, S.y) | ((unsigned long long)pk2(S.z, S.w) << 32);
            S = S * gch + v[i]; }
    }
}
__device__ __forceinline__ void ret_output(const bf16* PROJ, const bf16* Sbf, const float* dec_f, const float* dec_b, bf16* Y, LAS unsigned char* lds, int unit, int tid) {
    const int n = unit & 31, h = (unit >> 5) & 3, b = unit >> 7, lane = tid & 63, wave = __builtin_amdgcn_readfirstlane(tid >> 6), g = lane >> 4, li = lane & 15;
    LAS bf16* bufA = (LAS bf16*)lds; LAS bf16* bufC = bufA + 128 * LDT;
    const bf16* rowp = PROJ + (size_t)(b * SEQ + n * 128) * NP;
    const float lf2 = log2_gamma(dec_f[h]), lb2 = log2_gamma(dec_b[h]);
    stage_N<128, false>(rowp + C_QR + h * 128, NP, bufA, tid, 0.f, 0.f, 0.f);
    stage_N<128, false>(rowp + C_KR + h * 128, NP, bufC, tid, 0.f, 0.f, 0.f);
    __syncthreads();
    f32x4 sc[8];
#pragma unroll
    for (int nt = 0; nt < 8; ++nt) sc[nt] = (f32x4){0.f, 0.f, 0.f, 0.f};
    mma_lds<8, 4>(sc, bufA, LDT, 16 * wave, bufC, LDT, 0, lane);
    __syncthreads();
#pragma unroll
    for (int nt = 0; nt < 8; ++nt)
#pragma unroll
        for (int rg = 0; rg < 4; ++rg) { const int i = 16 * wave + 4 * g + rg, j = 16 * nt + li; const int dd = i - j;
            const float dm = (dd == 0) ? 2.0f : (dd > 0 ? exp2f(lf2 * (float)dd) : exp2f(lb2 * (float)(-dd)));
            bufA[i * LDT + j] = (bf16)f2bf(sc[nt][rg] * dm); }
    stage_T<8, false>(rowp + C_VR + h * 256, bufC, tid, 0.f, 0.f, 0.f);
    __syncthreads();
    f32x4 acc[16];
#pragma unroll
    for (int nt = 0; nt < 16; ++nt) acc[nt] = (f32x4){0.f, 0.f, 0.f, 0.f};
    mma_lds<16, 4>(acc, bufA, LDT, 16 * wave, bufC, LDT, 0, lane);
    __syncthreads();
#pragma unroll 1
    for (int dir = 0; dir < 2; ++dir) {
        if (dir == 0) stage_N<128, true>(rowp + C_QR + h * 128, NP, bufA, tid, lf2, 1.f, 1.f);
        else          stage_N<128, true>(rowp + C_QR + h * 128, NP, bufA, tid, lb2, 128.f, -1.f);
        stage_N<256, false>(Sbf + ((size_t)(((dir * 2 + b) * 4 + h) * 32 + n)) * 32768, 128, bufC, tid, 0.f, 0.f, 0.f);
        __syncthreads();
        mma_lds<16, 4>(acc, bufA, LDT, 16 * wave, bufC, LDT, 0, lane);
        __syncthreads();
    }
    constexpr int LDZ = 264;
    LAS bf16* zb = (LAS bf16*)lds;
#pragma unroll
    for (int it = 0; it < 8; ++it) { const int idx = tid + 512 * it, row = idx >> 5, c = idx & 31; *(LAS v4u*)(zb + row * LDZ + 8 * c) = *(const v4u*)(rowp + (size_t)row * NP + C_ZR + h * 256 + 8 * c); }
    float rn[4];
#pragma unroll
    for (int rg = 0; rg < 4; ++rg) { float ss = 0.f;
#pragma unroll
        for (int nt = 0; nt < 16; ++nt) ss += acc[nt][rg] * acc[nt][rg];
        ss += __shfl_xor(ss, 1); ss += __shfl_xor(ss, 2); ss += __shfl_xor(ss, 4); ss += __shfl_xor(ss, 8);
        rn[rg] = rsqrtf(ss * (1.0f / 256.0f) + EPS); }
    __syncthreads();
#pragma unroll
    for (int nt = 0; nt < 16; ++nt)
#pragma unroll
        for (int rg = 0; rg < 4; ++rg) { LAS bf16* p = zb + (16 * wave + 4 * g + rg) * LDZ + 16 * nt + li; *p = (bf16)f2bf(acc[nt][rg] * rn[rg] * silu_f(bf2f(*p))); }
    __syncthreads();
    bf16* yrow = Y + (size_t)(b * SEQ + n * 128) * D + 1024 + h * 256;
#pragma unroll
    for (int it = 0; it < 8; ++it) { const int idx = tid + 512 * it, row = idx >> 5, c = idx & 31; *(v4u*)(yrow + (size_t)row * D + 8 * c) = *(const LAS v4u*)(zb + row * LDZ + 8 * c); }
    __syncthreads();
}

__device__ __forceinline__ void ret_naive_scan(const bf16* PROJ, const float* dec_f, const float* dec_b, float* OUT, LAS unsigned char* lds, int unit, int tid) {
    const int dir = unit >> 3, b = (unit >> 2) & 1, h = unit & 3;
    const float logit = dir ? dec_b[h] : dec_f[h]; const float gamma = 1.0f / (1.0f + __expf(-logit));
    const int e = tid & 255, half = tid >> 8;
    LAS float* qk = (LAS float*)lds;
    LAS float* red = qk + 512;
    float S[64];
#pragma unroll
    for (int d = 0; d < 64; ++d) S[d] = 0.f;
    const int qkcol = (tid < 128) ? (C_QR + h * 128 + tid) : (C_KR + h * 128 + (tid & 127));
    int t0 = dir ? SEQ - 1 : 0;
    unsigned short nqk = PROJ[(size_t)(b * SEQ + t0) * NP + qkcol], nv = PROJ[(size_t)(b * SEQ + t0) * NP + C_VR + h * 256 + e];
    for (int step = 0; step < SEQ; ++step) {
        const int t = dir ? SEQ - 1 - step : step, m = b * SEQ + t, buf = step & 1;
        if (tid < 256) qk[buf * 256 + tid] = bf2f(nqk);
        const float ve = bf2f(nv);
        if (step + 1 < SEQ) { const int tn = dir ? t - 1 : t + 1; nqk = PROJ[(size_t)(b * SEQ + tn) * NP + qkcol]; nv = PROJ[(size_t)(b * SEQ + tn) * NP + C_VR + h * 256 + e]; }
        __syncthreads();
        float part = 0.f;
        const LAS float* qp = qk + buf * 256 + 64 * half; const LAS float* kp = qp + 128;
#pragma unroll
        for (int d = 0; d < 64; ++d) { S[d] = gamma * S[d] + kp[d] * ve; part += qp[d] * S[d]; }
        if (half == 1) red[buf * 256 + e] = part;
        __syncthreads();
        if (half == 0) OUT[((size_t)dir * M + m) * 1024 + h * 256 + e] = part + red[buf * 256 + e];
    }
}
__device__ __forceinline__ void ret_naive_combine(const float* OUT, const bf16* PROJ, bf16* Y, int gw, int NGW, int lane) {
    for (int item = gw; item < M * 4; item += NGW) {
        const int m = item >> 2, h = item & 3;
        const f32x4 a = *(const f32x4*)(OUT + (size_t)m * 1024 + h * 256 + 4 * lane), bq = *(const f32x4*)(OUT + ((size_t)M + m) * 1024 + h * 256 + 4 * lane);
        const f32x4 o = a + bq;
        const float r = rsqrtf(wave_sum((o.x * o.x + o.y * o.y) + (o.z * o.z + o.w * o.w)) * (1.0f / 256.0f) + EPS);
        const unsigned long long zz = *(const unsigned long long*)(PROJ + (size_t)m * NP + C_ZR + h * 256 + 4 * lane);
        const unsigned z0 = (unsigned)zz, z1 = (unsigned)(zz >> 32);
        const float y0 = o.x * r * silu_f(bf2f(z0 & 0xffffu)), y1 = o.y * r * silu_f(bf2f(z0 >> 16)), y2 = o.z * r * silu_f(bf2f(z1 & 0xffffu)), y3 = o.w * r * silu_f(bf2f(z1 >> 16));
        *(unsigned long long*)(Y + (size_t)m * D + 1024 + h * 256 + 4 * lane) = (unsigned long long)pk2(y0, y1) | ((unsigned long long)pk2(y2, y3) << 32);
    }
}

struct Args { const float* in[10]; float* out; unsigned char* ws; int ph_lo, ph_hi, use_bar, pad; };
constexpr int N_PHASES = 2 + 5 * DEPTH;

__device__ __forceinline__ unsigned char* ld_ptr(volatile LAS unsigned* tab, int i) {
    unsigned lo = tab[2 * i], hi = tab[2 * i + 1];
    lo = __builtin_amdgcn_readfirstlane(lo); hi = __builtin_amdgcn_readfirstlane(hi);
    return (unsigned char*)(((unsigned long long)hi << 32) | lo);
}
__global__ void __launch_bounds__(NWAVES * 64, 2) fwd_kernel(Args args) {
    extern __shared__ __attribute__((aligned(16))) unsigned char lds_raw[];
    LAS unsigned char* lds = (LAS unsigned char*)lds_raw;
    const int tid = threadIdx.x;
    volatile LAS unsigned* MISC = (volatile LAS unsigned*)(lds + MISC_OFF);
    volatile LAS unsigned* TAB = MISC + 32;
    for (int u = tid; u < (LDS_BYTES - RING_BYTES) / 4; u += NWAVES * 64) ((LAS unsigned*)(lds + RING_BYTES))[u] = 0u;
    __syncthreads();
    if (tid < 12) { const unsigned long long v = (tid < 10) ? (unsigned long long)args.in[tid] : (tid == 10 ? (unsigned long long)args.out : (unsigned long long)args.ws);
        TAB[2 * tid] = (unsigned)v; TAB[2 * tid + 1] = (unsigned)(v >> 32); }
    __syncthreads();
    if (tid == 0) { MISC[11] = (unsigned)args.ph_lo; MISC[12] = (unsigned)args.ph_hi; MISC[13] = (unsigned)args.use_bar; }
    if (args.use_bar) { const XcdBarrier b0 = xcd_barrier_post((unsigned*)(args.ws + WS_CTL) + CW_BAR, MISC + 8); if (tid == 0) MISC[10] = b0.x; }
    __syncthreads();
#define CFG(i) ((int)__builtin_amdgcn_readfirstlane(MISC[(i)]))
#define IN(k) (CFG(11) <= (k) && (k) < CFG(12))
#define GRID_BAR() do { if (CFG(13)) { XcdBarrier b_; b_.bar = (unsigned*)(ld_ptr(TAB, 11) + WS_CTL) + CW_BAR; b_.x = (unsigned)CFG(10); b_.st = MISC + 8; xcd_barrier(b_); } } while (0)
#define PTR(i) ld_ptr(TAB, (i))
#define WAVE_IDS() int t__ = threadIdx.x; asm volatile("" : "+v"(t__)); const int lane = t__ & 63, wave = __builtin_amdgcn_readfirstlane(t__ >> 6), gw = blockIdx.x * NWAVES + wave, NGW = gridDim.x * NWAVES

    if (IN(0)) {
        WAVE_IDS(); unsigned char* ws = PTR(11);
        p0_gemv((const float*)PTR(1), (const float*)PTR(3), (const float*)PTR(4), (float*)(ws + WS_MOD), lds, blockIdx.x, t__);
        p0_transposes((const float*)PTR(5), (const float*)PTR(6), (bf16*)(ws + WS_WIN), (bf16*)(ws + WS_WOUT), lds, gw, NGW, wave, lane);
        __syncthreads();
        if (CFG(13)) cg::this_grid().sync();
        GRID_BAR();
    }
    for (int l = 0; l < DEPTH; ++l) {
        const int pb = 1 + 5 * l;
        if (IN(pb + 0)) { WAVE_IDS(); unsigned char* ws = PTR(11);
            norm_rows<false>((l == 0) ? (const float*)PTR(0) : (const float*)(ws + WS_X), (const float*)PTR(2) + l * D, (const float*)(ws + WS_MOD) + (size_t)l * 2 * MODW, (bf16*)(ws + WS_HN), nullptr, gw, NGW, lane);
            GRID_BAR(); }
        if (IN(pb + 1)) { unsigned char* ws = PTR(11);
            pg8::Gemm g{(const bf16*)(ws + WS_HN), (const bf16*)(ws + WS_WIN) + (size_t)l * NP * D, M, NP, D}; pg8::StaticOrder S; S.init(M, NP, gridDim.x, blockIdx.x);
            pg8::EpiProj E{(bf16*)(ws + WS_PROJ), NP};
            pg8::gemm_phase<pg8::EpiProj, pg8::StaticOrder, true, true>(lds, g, S, E);
            GRID_BAR();
        }
        if (IN(pb + 2)) { WAVE_IDS(); unsigned char* ws = PTR(11);
#if NAIVE_RET
            if (blockIdx.x < 16) ret_naive_scan((const bf16*)(ws + WS_PROJ), (const float*)PTR(7) + l * 4, (const float*)PTR(8) + l * 4, (float*)(ws + WS_RET), lds, blockIdx.x, t__);
            __syncthreads();
#else
            for (int u = blockIdx.x; u < NB * 4 * 32; u += gridDim.x) ret_chunk_state((const bf16*)(ws + WS_PROJ), (const float*)PTR(7) + l * 4, (const float*)PTR(8) + l * 4, (float*)(ws + WS_RET), lds, u, t__);
#endif
#if NAIVE_ATT
            attn_naive((const bf16*)(ws + WS_PROJ), (bf16*)(ws + WS_Y), lds, gw, NGW, wave, lane);
#else
            for (int u = blockIdx.x; u < NB * 8 * 16; u += gridDim.x) attn_unit((const bf16*)(ws + WS_PROJ), (bf16*)(ws + WS_Y), u, lds + wave * 16384, wave, lane);
#endif
            GRID_BAR();
        }
        if (IN(pb + 3)) { WAVE_IDS(); unsigned char* ws = PTR(11);
#if NAIVE_RET
            ret_naive_combine((const float*)(ws + WS_RET), (const bf16*)(ws + WS_PROJ), (bf16*)(ws + WS_Y), gw, NGW, lane);
#else
            for (int gt = blockIdx.x * 512 + t__; gt < 16 * 8192; gt += gridDim.x * 512)
                ret_scan((const float*)(ws + WS_RET), (bf16*)(ws + WS_RET + 64 * MiB), (const float*)PTR(7) + l * 4, (const float*)PTR(8) + l * 4, gt);
            GRID_BAR();
            for (int u = blockIdx.x; u < NB * 4 * 32; u += gridDim.x) ret_output((const bf16*)(ws + WS_PROJ), (const bf16*)(ws + WS_RET + 64 * MiB), (const float*)PTR(7) + l * 4, (const float*)PTR(8) + l * 4, (bf16*)(ws + WS_Y), lds, u, t__);
#endif
            GRID_BAR();
        }
        if (IN(pb + 4)) { unsigned char* ws = PTR(11);
            pg8::Gemm g{(const bf16*)(ws + WS_Y), (const bf16*)(ws + WS_WOUT) + (size_t)l * D * D, M, D, D}; pg8::StaticOrder S; S.init(M, D, gridDim.x, blockIdx.x);
            pg8::EpiResid E{(l == 0) ? (const float*)PTR(0) : (const float*)(ws + WS_X), (float*)(ws + WS_X), (const float*)(ws + WS_MOD) + (size_t)l * 2 * MODW + 2 * D, D, SEQ, MODW};
            pg8::gemm_phase<pg8::EpiResid, pg8::StaticOrder, true, true>(lds, g, S, E);
            GRID_BAR();
        }
    }
    if (IN(N_PHASES - 1)) { WAVE_IDS(); unsigned char* ws = PTR(11);
        norm_rows<true>((const float*)(ws + WS_X), (const float*)PTR(9), nullptr, nullptr, (float*)PTR(10), gw, NGW, lane); }
#undef IN
#undef GRID_BAR
}

extern "C" void kernel_launch(void* const* d_in, const int* in_sizes, int n_in, void* d_out, int out_size, void* d_ws, size_t ws_size, hipStream_t stream) {
    static int grid = 0;
    if (grid == 0) {
        if (n_in != 10 || out_size != M * D || ws_size < WS_END) { fprintf(stderr, "kernel_launch: unexpected shapes (n_in %d out %d ws %zu)\n", n_in, out_size, ws_size); grid = -1; return; }
        int dev = 0, cus = 0, per_cu = 0;
        hipGetDevice(&dev); hipDeviceGetAttribute(&cus, hipDeviceAttributeMultiprocessorCount, dev);
        if (hipFuncSetAttribute((const void*)fwd_kernel, hipFuncAttributeMaxDynamicSharedMemorySize, LDS_BYTES) != hipSuccess) { fprintf(stderr, "kernel_launch: hipFuncSetAttribute failed\n"); grid = -1; return; }
        if (hipOccupancyMaxActiveBlocksPerMultiprocessor(&per_cu, (const void*)fwd_kernel, NWAVES * 64, LDS_BYTES) != hipSuccess || per_cu < 1) { fprintf(stderr, "kernel_launch: occupancy query says %d\n", per_cu); per_cu = 1; }
        (void)hipGetLastError();
        grid = cus * 1;
        fprintf(stderr, "kernel_launch: grid %d (cus %d, per_cu %d)\n", grid, cus, per_cu);
    }
    if (grid < 0) return;
    Args a{};
    for (int i = 0; i < 10; ++i) a.in[i] = (const float*)d_in[i];
    a.out = (float*)d_out; a.ws = (unsigned char*)d_ws;
#if ONE_LAUNCH
    if (hipMemsetAsync((char*)d_ws + WS_CTL, 0, CTL_ZERO_BYTES, stream) != hipSuccess) { fprintf(stderr, "kernel_launch: memset failed\n"); return; }
    a.ph_lo = 0; a.ph_hi = N_PHASES; a.use_bar = 1;
    void* kargs[] = {&a};
    hipError_t e = hipLaunchCooperativeKernel((const void*)fwd_kernel, dim3(grid), dim3(NWAVES * 64), kargs, LDS_BYTES, stream);
    if (e != hipSuccess) fprintf(stderr, "kernel_launch: cooperative launch failed: %s (grid %d)\n", hipGetErrorString(e), grid);
#else
    for (int ph = 0; ph < N_PHASES; ++ph) {
        a.ph_lo = ph; a.ph_hi = ph + 1; a.use_bar = 0;
        hipLaunchKernelGGL(fwd_kernel, dim3(grid), dim3(NWAVES * 64), LDS_BYTES, stream, a);
    }
#endif
}
```

```cpp
#include <hip/hip_runtime.h>
#include <hip/hip_cooperative_groups.h>
#include <cstdio>
#include <cstdint>
namespace cg = cooperative_groups;
#define ONE_LAUNCH 1
#define NAIVE_ATT 0
#define NAIVE_RET 0
namespace pg8 {
#define PG8_LAS __attribute__((address_space(3)))
typedef unsigned short bf16_t;
typedef short bf16x8 __attribute__((ext_vector_type(8)));
typedef float f32x4 __attribute__((ext_vector_type(4)));
typedef unsigned u32x4 __attribute__((ext_vector_type(4)));
constexpr int BM = 256, BK = 64, HALF = 128, HTB = HALF * BK * 2  , STAGE_BYTES = 8 * HTB, NXCD = 8, WGM = 8;

__host__ __device__ __forceinline__ int lds_byte(int r, int c) { const int st = (r >> 4) * 2 + (c >> 5), rr = r & 15, cc = c & 31, ob = rr * 64 + cc * 2; return st * 1024 + (ob ^ (((ob >> 9) & 1) << 5)); }
__host__ __device__ __forceinline__ void stage_rc(int b, int& R, int& C) { const int st = b / 1024, sb = b % 1024, swz = sb ^ (((sb >> 9) & 1) << 5); R = (st >> 1) * 16 + swz / 64; C = (st & 1) * 32 + (swz % 64) / 2; }
__host__ __device__ __forceinline__ int perm32(int rho) { const int n = rho >> 4, i = rho & 15; return 8 * (i >> 2) + 4 * n + (i & 3); }

struct Unit { int pm, pn; };
struct Gemm { const bf16_t* A; const bf16_t* Bt; int M, N, K; };

struct StaticOrder {
    int nM, nN, nwg, G, c;
    __host__ __device__ void init(int M, int N, int G_, int c_) { nM = M / BM; nN = N / BM; nwg = nM * nN; G = G_; c = c_; }
    __host__ __device__ bool next(int i, Unit& u) const {
        const long L = (long)i * G + c; if (L >= nwg) return false;
        int wgid = (int)L; { const int q = nwg / NXCD, r = nwg % NXCD, xcd = wgid % NXCD, off = wgid / NXCD; wgid = (xcd < r ? xcd * (q + 1) : r * (q + 1) + (xcd - r) * q) + off; }
        const int nig = WGM * nN, gid = wgid / nig, fm = gid * WGM, gsz = (nM - fm) < WGM ? (nM - fm) : WGM;
        u.pm = fm + ((wgid % nig) % gsz); u.pn = (wgid % nig) / gsz; return true;
    }
    __device__ __forceinline__ void a_ready(const Unit&) const {}
    __device__ __forceinline__ void done(const Unit&) const {}
};

__device__ __forceinline__ unsigned cvt_pk_bf16(float lo, float hi) { unsigned r; asm volatile("v_cvt_pk_bf16_f32 %0, %1, %2" : "=v"(r) : "v"(lo), "v"(hi)); return r; }
typedef float f32x2 __attribute__((ext_vector_type(2)));
__device__ __forceinline__ f32x2 gelu_pk(f32x2 v) {
    const f32x2 av = __builtin_elementwise_abs(v), d = av * 0.2316418882f + 1.0f;
    f32x2 t; t.x = __builtin_amdgcn_rcpf(d.x); t.y = __builtin_amdgcn_rcpf(d.y);
    f32x2 q = t * 0.5307027145f + (-0.7265760135f); q = q * t + 0.7107068705f; q = q * t + (-0.142248368f); q = q * t + 0.127414796f; q = q * t;
    const f32x2 s = (v * v) * (-0.72134752044f);
    f32x2 e; e.x = __builtin_amdgcn_exp2f(s.x); e.y = __builtin_amdgcn_exp2f(s.y);
    const f32x2 m = v * (q * e), r = v - m;
    f32x2 o; o.x = v.x < 0.f ? m.x : r.x; o.y = v.y < 0.f ? m.y : r.y; return o;
}

template <int ACT  > struct EpiBf16 {
    static constexpr bool PERM = true, AFTER_DRAIN = false; static_assert(ACT == 0 || ACT == 1, "EpiBf16: ACT is 0 (none) or 1 (gelu_pk)");
    bf16_t* O; int ldc; const float* bias; int split_cols; size_t split_stride; float scale0;
    __device__ __forceinline__ void operator()(const f32x4 (&acc)[2][2][4][2], const Unit& u, int wr, int wc, int fr, int fq) const {
        const int row0 = u.pm * BM + wr * 64 + fr; int colt = u.pn * BM; bf16_t* base = O;
        float sc = 1.f; if (split_cols) { const int t = colt / split_cols; base += (size_t)t * split_stride; colt -= t * split_cols; if (t == 0) sc = scale0; }
        const int col0 = colt + wc * 32 + 8 * fq, bcol0 = u.pn * BM + wc * 32 + 8 * fq;
        f32x4 bv[2][2];
#pragma unroll
        for (int bj = 0; bj < 2; ++bj)
#pragma unroll
            for (int n = 0; n < 2; ++n) bv[bj][n] = bias ? *(const f32x4*)(bias + bcol0 + bj * HALF + 4 * n) : (f32x4){0.f, 0.f, 0.f, 0.f};
#pragma unroll
        for (int ai = 0; ai < 2; ++ai)
#pragma unroll
            for (int m = 0; m < 4; ++m) { bf16_t* rowp = base + (size_t)(row0 + ai * HALF + m * 16) * ldc + col0;
#pragma unroll
                for (int bj = 0; bj < 2; ++bj) { f32x4 v0 = acc[ai][bj][m][0] + bv[bj][0], v1 = acc[ai][bj][m][1] + bv[bj][1];
                    if (ACT == 1) { f32x2 a = gelu_pk((f32x2){v0[0], v0[1]}), b = gelu_pk((f32x2){v0[2], v0[3]}), c = gelu_pk((f32x2){v1[0], v1[1]}), d = gelu_pk((f32x2){v1[2], v1[3]});
                        v0 = (f32x4){a.x, a.y, b.x, b.y}; v1 = (f32x4){c.x, c.y, d.x, d.y}; }
                    v0 = v0 * sc; v1 = v1 * sc; u32x4 w; w.x = cvt_pk_bf16(v0[0], v0[1]); w.y = cvt_pk_bf16(v0[2], v0[3]); w.z = cvt_pk_bf16(v1[0], v1[1]); w.w = cvt_pk_bf16(v1[2], v1[3]);
                    *(u32x4*)(rowp + bj * HALF) = w; } }
    }
};
struct EpiProj {
    static constexpr bool PERM = true, AFTER_DRAIN = false;
    bf16_t* O; int ldc;
    __device__ __forceinline__ void operator()(const f32x4 (&acc)[2][2][4][2], const Unit& u, int wr, int wc, int fr, int fq) const {
        const int row0 = u.pm * BM + wr * 64 + fr; const int col0 = u.pn * BM + wc * 32 + 8 * fq;
        const float sc = (u.pn < 4) ? 0.12751743074602468f : ((u.pn == 18 || u.pn == 19) ? 0.08838834764831845f : 1.0f);
#pragma unroll
        for (int ai = 0; ai < 2; ++ai)
#pragma unroll
            for (int m = 0; m < 4; ++m) { bf16_t* rowp = O + (size_t)(row0 + ai * HALF + m * 16) * ldc + col0;
#pragma unroll
                for (int bj = 0; bj < 2; ++bj) { f32x4 v0 = acc[ai][bj][m][0] * sc, v1 = acc[ai][bj][m][1] * sc;
                    u32x4 w; w.x = cvt_pk_bf16(v0[0], v0[1]); w.y = cvt_pk_bf16(v0[2], v0[3]); w.z = cvt_pk_bf16(v1[0], v1[1]); w.w = cvt_pk_bf16(v1[2], v1[3]);
                    *(u32x4*)(rowp + bj * HALF) = w; } }
    }
};
struct EpiResid {
    static constexpr bool PERM = false, AFTER_DRAIN = false;
    const float* base; float* out; const float* gate; int ldc, rows_per_batch, gate_stride;
    __device__ __forceinline__ void operator()(const f32x4 (&acc)[2][2][4][2], const Unit& u, int wr, int wc, int fr, int fq) const {
        const int col0 = u.pn * BM + wc * 32 + 4 * fq; const int b = (u.pm * BM) / rows_per_batch;
        f32x4 gv[2][2];
#pragma unroll
        for (int bj = 0; bj < 2; ++bj)
#pragma unroll
            for (int n = 0; n < 2; ++n) gv[bj][n] = *(const f32x4*)(gate + (size_t)b * gate_stride + col0 + bj * HALF + n * 16);
#pragma unroll
        for (int ai = 0; ai < 2; ++ai)
#pragma unroll
            for (int m = 0; m < 4; ++m) { const size_t off = (size_t)(u.pm * BM + ai * HALF + wr * 64 + m * 16 + fr) * ldc + col0;
#pragma unroll
                for (int bj = 0; bj < 2; ++bj)
#pragma unroll
                    for (int n = 0; n < 2; ++n) { const f32x4 bs = *(const f32x4*)(base + off + bj * HALF + n * 16);
                        *(f32x4*)(out + off + bj * HALF + n * 16) = bs + gv[bj][n] * acc[ai][bj][m][n]; } }
    }
};
template <class Epi, class Sched, bool ALIGN_EPI = false, bool SP2 = false>
__device__ __forceinline__ void gemm_phase(PG8_LAS unsigned char* lds, const Gemm g, const Sched& S, const Epi& E, int tid_in) {
    int tid_l = tid_in; asm volatile("" : "+v"(tid_l));
    const int tid = tid_l, wid = __builtin_amdgcn_readfirstlane(tid >> 6), lane = tid & 63, wr = wid >> 2, wc = wid & 3, fr = lane & 15, fq = lane >> 4;
    const int K = g.K, nt = K / BK;
    unsigned voffA[2], voffB[2];
#pragma unroll
    for (int i = 0; i < 2; ++i) { int R, C; stage_rc(tid * 16 + i * 8192, R, C); const int Rb = Epi::PERM ? ((R & ~31) + perm32(R & 31)) : R;
        voffA[i] = (unsigned)(R * K + C) * 2u; voffB[i] = (unsigned)(Rb * K + C) * 2u; }
    const size_t kstep = (size_t)(BK * 2);
    const size_t hstep = (size_t)HALF * K * 2;
    const size_t tstep = 2 * hstep;
    const unsigned ldsw = (unsigned)wid * 1024u;
    const int aoff = lds_byte(wr * 64 + fr, fq * 8), boff = lds_byte(wc * 32 + fr, fq * 8);
#define PG8_SA(b, h) (((b) * 2 + (h)) * HTB)
#define PG8_SB(b, h) ((4 + (b) * 2 + (h)) * HTB)
#define PG8_STAGE(bufoff, gbase, voff) do { _Pragma("unroll") for (int _i = 0; _i < 2; ++_i) \
        __builtin_amdgcn_global_load_lds((const unsigned*)((const char*)(gbase) + (voff)[_i]), (PG8_LAS unsigned*)(lds + (bufoff) + ldsw + _i * 8192), 16, 0, 0); } while (0)
#define PG8_LDA(dst, b, h) do { _Pragma("unroll") for (int m = 0; m < 4; ++m) _Pragma("unroll") for (int k = 0; k < 2; ++k) dst[m][k] = *(const PG8_LAS bf16x8*)(lds + PG8_SA(b, h) + aoff + m * 2048 + k * 1024); } while (0)
#define PG8_LDB(dst, b, h) do { _Pragma("unroll") for (int n = 0; n < 2; ++n) _Pragma("unroll") for (int k = 0; k < 2; ++k) dst[n][k] = *(const PG8_LAS bf16x8*)(lds + PG8_SB(b, h) + boff + n * 2048 + k * 1024); } while (0)
#define PG8_MMA(ai, bj, At, Bt) do { __builtin_amdgcn_s_setprio(1); _Pragma("unroll") for (int m = 0; m < 4; ++m) _Pragma("unroll") for (int n = 0; n < 2; ++n) _Pragma("unroll") for (int k = 0; k < 2; ++k) \
        acc[ai][bj][m][n] = __builtin_amdgcn_mfma_f32_16x16x32_bf16(Bt[n][k], At[m][k], acc[ai][bj][m][n], 0, 0, 0); __builtin_amdgcn_s_setprio(0); } while (0)
#define PG8_WAIT_V(n) asm volatile("s_waitcnt vmcnt(" #n ")" ::: "memory")
#define PG8_WAIT_L(n) asm volatile("s_waitcnt lgkmcnt(" #n ")" ::: "memory")
#define PG8_BAR __builtin_amdgcn_s_barrier()
#define PG8_SCHED __builtin_amdgcn_sched_barrier(0)
    Unit cur, nxt; int ui = 0;
    if (!S.next(0, cur)) return;
    f32x4 acc[2][2][4][2];
#pragma unroll
    for (int a = 0; a < 2; ++a)
#pragma unroll
        for (int b = 0; b < 2; ++b)
#pragma unroll
            for (int m = 0; m < 4; ++m)
#pragma unroll
                for (int n = 0; n < 2; ++n) acc[a][b][m][n] = (f32x4){0.f, 0.f, 0.f, 0.f};
    bf16x8 At[4][2], B0[2][2], B1[2][2];
    const char* cA = (const char*)g.A + (size_t)cur.pm * tstep; const char* cB = (const char*)g.Bt + (size_t)cur.pn * tstep;
    S.a_ready(cur);
    if constexpr (SP2) {
        PG8_STAGE(PG8_SB(0, 0), cB, voffB); PG8_STAGE(PG8_SB(0, 1), cB + hstep, voffB); PG8_STAGE(PG8_SA(0, 0), cA, voffA); PG8_STAGE(PG8_SA(0, 1), cA + hstep, voffA);
        if (wr == 1) PG8_BAR;
        PG8_WAIT_V(2); PG8_BAR;
        PG8_STAGE(PG8_SB(1, 0), cB + kstep, voffB); PG8_STAGE(PG8_SA(1, 0), cA + kstep, voffA); PG8_STAGE(PG8_SB(1, 1), cB + hstep + kstep, voffB);
        PG8_WAIT_V(6); PG8_BAR;
    } else {
        PG8_STAGE(PG8_SB(0, 0), cB, voffB); PG8_STAGE(PG8_SA(0, 0), cA, voffA); PG8_STAGE(PG8_SB(0, 1), cB + hstep, voffB); PG8_STAGE(PG8_SA(0, 1), cA + hstep, voffA);
        if (wr == 1) PG8_BAR;
        PG8_WAIT_V(4); PG8_BAR;
        PG8_STAGE(PG8_SB(1, 0), cB + kstep, voffB); PG8_STAGE(PG8_SA(1, 0), cA + kstep, voffA); PG8_STAGE(PG8_SB(1, 1), cB + hstep + kstep, voffB);
        PG8_WAIT_V(6); PG8_BAR;
    }
    for (;;) {
        const bool has_next = S.next(ui + 1, nxt);
        const char* nA = has_next ? (const char*)g.A + (size_t)nxt.pm * tstep : cA; const char* nB = has_next ? (const char*)g.Bt + (size_t)nxt.pn * tstep : cB;
        for (int t = 0; t < nt; t += 2) {
            const bool last = (t == nt - 2);
            const char* a1 = cA + (size_t)(t + 1) * kstep;
            const char* a2 = last ? nA : cA + (size_t)(t + 2) * kstep; const char* b2 = last ? nB : cB + (size_t)(t + 2) * kstep;
            const char* a3 = a2 + kstep; const char* b3 = b2 + kstep;
            if (last && has_next) S.a_ready(nxt);
            if constexpr (SP2) {
            PG8_LDB(B0, 0, 0); PG8_LDB(B1, 0, 1); PG8_SCHED; PG8_LDA(At, 0, 0); PG8_STAGE(PG8_SA(1, 1), a1 + hstep, voffA);
            PG8_WAIT_V(8); PG8_WAIT_L(0); PG8_BAR; PG8_MMA(0, 0, At, B0); PG8_MMA(0, 1, At, B1); PG8_BAR; PG8_SCHED;
            PG8_LDA(At, 0, 1); PG8_STAGE(PG8_SB(0, 0), b2, voffB); PG8_STAGE(PG8_SB(0, 1), b2 + hstep, voffB); PG8_STAGE(PG8_SA(0, 0), a2, voffA);
            PG8_WAIT_V(8); PG8_WAIT_L(0); PG8_BAR; PG8_MMA(1, 0, At, B0); PG8_MMA(1, 1, At, B1); PG8_BAR; PG8_SCHED;
            PG8_LDB(B0, 1, 0); PG8_LDB(B1, 1, 1); PG8_SCHED; PG8_LDA(At, 1, 0); PG8_STAGE(PG8_SA(0, 1), a2 + hstep, voffA);
            PG8_WAIT_V(8); PG8_WAIT_L(0); PG8_BAR; PG8_MMA(0, 0, At, B0); PG8_MMA(0, 1, At, B1); PG8_BAR; PG8_SCHED;
            PG8_LDA(At, 1, 1); PG8_STAGE(PG8_SB(1, 0), b3, voffB); PG8_STAGE(PG8_SB(1, 1), b3 + hstep, voffB); PG8_STAGE(PG8_SA(1, 0), a3, voffA);
            PG8_WAIT_V(8); PG8_WAIT_L(0); PG8_BAR; PG8_MMA(1, 0, At, B0); PG8_MMA(1, 1, At, B1); PG8_BAR; PG8_SCHED;
            } else {
            PG8_LDB(B0, 0, 0); PG8_SCHED; PG8_LDA(At, 0, 0); PG8_STAGE(PG8_SA(1, 1), a1 + hstep, voffA);
            PG8_WAIT_L(8); PG8_BAR; PG8_WAIT_L(0); PG8_MMA(0, 0, At, B0); PG8_BAR; PG8_SCHED;
            PG8_LDB(B1, 0, 1); PG8_STAGE(PG8_SB(0, 0), b2, voffB);
            PG8_BAR; PG8_WAIT_L(0); PG8_MMA(0, 1, At, B1); PG8_BAR;
            PG8_LDA(At, 0, 1); PG8_STAGE(PG8_SA(0, 0), a2, voffA);
            PG8_BAR; PG8_WAIT_L(0); PG8_MMA(1, 0, At, B0); PG8_BAR; PG8_SCHED;
            PG8_STAGE(PG8_SB(0, 1), b2 + hstep, voffB);
            PG8_WAIT_V(6); PG8_BAR; PG8_MMA(1, 1, At, B1); PG8_BAR;
            PG8_LDB(B0, 1, 0); PG8_SCHED; PG8_LDA(At, 1, 0); PG8_STAGE(PG8_SA(0, 1), a2 + hstep, voffA);
            PG8_WAIT_L(8); PG8_BAR; PG8_WAIT_L(0); PG8_MMA(0, 0, At, B0); PG8_BAR; PG8_SCHED;
            PG8_LDB(B1, 1, 1); PG8_STAGE(PG8_SB(1, 0), b3, voffB);
            PG8_BAR; PG8_WAIT_L(0); PG8_MMA(0, 1, At, B1); PG8_BAR;
            PG8_LDA(At, 1, 1); PG8_STAGE(PG8_SA(1, 0), a3, voffA);
            PG8_BAR; PG8_WAIT_L(0); PG8_MMA(1, 0, At, B0); PG8_BAR; PG8_SCHED;
            PG8_STAGE(PG8_SB(1, 1), b3 + hstep, voffB);
            PG8_WAIT_V(6); PG8_BAR; PG8_MMA(1, 1, At, B1); PG8_BAR;
            }
        }
        if constexpr (ALIGN_EPI) { if (wr == 0) PG8_BAR; }
        if constexpr (!Epi::AFTER_DRAIN) { E(acc, cur, wr, wc, fr, fq); S.done(cur); }
        if (!has_next) break;
#pragma unroll
        for (int a = 0; a < 2; ++a)
#pragma unroll
            for (int b = 0; b < 2; ++b)
#pragma unroll
                for (int m = 0; m < 4; ++m)
#pragma unroll
                    for (int n = 0; n < 2; ++n) acc[a][b][m][n] = (f32x4){0.f, 0.f, 0.f, 0.f};
        cur = nxt; cA = nA; cB = nB; ++ui;
        if constexpr (ALIGN_EPI) { if (wr == 1) PG8_BAR; }
    }
    PG8_WAIT_V(0);
    if constexpr (!ALIGN_EPI) { if (wr == 0) PG8_BAR; }
    PG8_BAR;
    if constexpr (Epi::AFTER_DRAIN) { E.fused(acc, cur, wr, wc, fr, fq, lds, wid, lane); S.done(cur); }
#undef PG8_SA
#undef PG8_SB
#undef PG8_STAGE
#undef PG8_LDA
#undef PG8_LDB
#undef PG8_MMA
#undef PG8_WAIT_V
#undef PG8_WAIT_L
#undef PG8_BAR
#undef PG8_SCHED
}
}
#define GAS __attribute__((address_space(1)))
#define LAS __attribute__((address_space(3)))
typedef unsigned short bf16;
typedef unsigned v4u __attribute__((ext_vector_type(4)));
typedef float f32x4 __attribute__((ext_vector_type(4)));
typedef short bf16x8 __attribute__((ext_vector_type(8)));
typedef GAS unsigned gu32;
typedef GAS unsigned long long gu64;
#define RLX_AGENT __ATOMIC_RELAXED, __HIP_MEMORY_SCOPE_AGENT
#define LDS_WAIT() asm volatile("s_waitcnt lgkmcnt(0)" ::: "memory")
#define VM_WAIT() asm volatile("s_waitcnt vmcnt(0)" ::: "memory")
__device__ __forceinline__ unsigned long long rt() { return __builtin_amdgcn_s_memrealtime(); }
__device__ __forceinline__ unsigned f2bf(float f) { unsigned u = __builtin_bit_cast(unsigned, f); return (u + 0x7fffu + ((u >> 16) & 1u)) >> 16; }
__device__ __forceinline__ unsigned pk2(float lo, float hi) { return f2bf(lo) | (f2bf(hi) << 16); }

#define XB_TMO      128
#define XB_XCNT(j)  (256  + 64 * (j))
#define XB_XSUB(j)  (1280 + 64 * (j))
#define XB_XGEN(j)  (2304 + 64 * (j))
#define XB_TOP      3328
#define XB_TOPGEN   3392
#define XCD_BAR_WORDS 3456
#define XB_SPIN_CAP (1u << 18)

__device__ __forceinline__ unsigned xb_ld(unsigned* p)              { return __hip_atomic_load(p, __ATOMIC_RELAXED, __HIP_MEMORY_SCOPE_AGENT); }
__device__ __forceinline__ unsigned xb_add(unsigned* p, unsigned v) { return __hip_atomic_fetch_add(p, v, __ATOMIC_RELAXED, __HIP_MEMORY_SCOPE_AGENT); }
__device__ __forceinline__ unsigned xb_xcc_id() { return (unsigned)__builtin_amdgcn_s_getreg((3 << 11) | 20) & 0xFu; }
#define XB_SPIN(cond, bar) do { unsigned _sp = 0; while (cond) { __builtin_amdgcn_s_sleep(1); \
    if ((++_sp & 255u) == 0u) { if (xb_ld(&(bar)[XB_TMO])) break; if (_sp > XB_SPIN_CAP) { atomicAdd(&(bar)[XB_TMO], 1u); break; } } } } while (0)

struct XcdBarrier {
    unsigned* bar; unsigned x;
    volatile LAS unsigned* st;
};

__device__ __forceinline__ XcdBarrier xcd_barrier_post(unsigned* bar, volatile LAS unsigned* st) {
    XcdBarrier b; b.bar = bar; b.x = xb_xcc_id(); b.st = st;
    if (threadIdx.x == 0) (void)xb_add(&bar[XB_XCNT(b.x)], 1u);
    return b;
}
__device__ __forceinline__ void xcd_barrier_complete(unsigned* bar, unsigned x, unsigned& nloc, unsigned& nx) {
    const unsigned G = gridDim.x * gridDim.y * gridDim.z;
    unsigned sum, cnt, mine, sp = 0u;
    for (;;) {
        sum = 0u; cnt = 0u; mine = 0u;
#pragma unroll
        for (unsigned j = 0; j < 16; ++j) { const unsigned c = xb_ld(&bar[XB_XCNT(j)]); sum += c; cnt += (c > 0u) ? 1u : 0u; mine = (j == x) ? c : mine; }
        if (sum == G) break;
        __builtin_amdgcn_s_sleep(1);
        if ((++sp & 255u) == 0u) { if (xb_ld(&bar[XB_TMO])) break; if (sp > XB_SPIN_CAP) { atomicAdd(&bar[XB_TMO], 1u); break; } }
    }
    nloc = mine > 0u ? mine : 1u; nx = cnt > 0u ? cnt : 1u;
}

__device__ __forceinline__ void xcd_barrier(const XcdBarrier& b) {
    asm volatile("s_waitcnt vmcnt(0)" ::: "memory");
    __syncthreads();
    if (threadIdx.x == 0) {
        unsigned* bar = b.bar;
        __builtin_amdgcn_s_waitcnt(0);
        unsigned nloc = b.st[0], nx = b.st[1];
        if (nloc == 0u) { xcd_barrier_complete(bar, b.x, nloc, nx); b.st[0] = nloc; b.st[1] = nx; }
        const unsigned old = xb_add(&bar[XB_XSUB(b.x)], 1u);
        const unsigned gen = old / nloc;
        if (old + 1u == (gen + 1u) * nloc) {
            __builtin_amdgcn_fence(__ATOMIC_RELEASE, "agent");
            asm volatile("s_waitcnt vmcnt(0)" ::: "memory");
            const unsigned og = xb_add(&bar[XB_TOP], 1u);
            const unsigned tg = og / nx;
            if (og + 1u == (tg + 1u) * nx) xb_add(&bar[XB_TOPGEN], 1u);
            else XB_SPIN(xb_ld(&bar[XB_TOPGEN]) == tg, bar);
            __builtin_amdgcn_fence(__ATOMIC_ACQUIRE, "agent");
            xb_add(&bar[XB_XGEN(b.x)], 1u);
            asm volatile("s_waitcnt vmcnt(0)" ::: "memory");
        } else {
            XB_SPIN(xb_ld(&bar[XB_XGEN(b.x)]) == gen, bar);
            __builtin_amdgcn_fence(__ATOMIC_ACQUIRE, "agent");
            asm volatile("s_waitcnt vmcnt(0)" ::: "memory");
        }
    }
    __syncthreads();
}
constexpr int NWAVES = 8;
constexpr int NB = 2, SEQ = 4096, M = NB * SEQ, D = 2048, NP = 7168, DEPTH = 4, MODW = 3 * D;
constexpr int C_QA = 0, C_KA = 1024, C_VA = 2048, C_ZA = 3072, C_QR = 4096, C_KR = 4608, C_VR = 5120, C_ZR = 6144;
constexpr float EPS = 1e-6f;
#ifndef ONE_LAUNCH
#define ONE_LAUNCH 1
#endif
#ifndef NAIVE_ATT
#define NAIVE_ATT 1
#endif
#ifndef NAIVE_RET
#define NAIVE_RET 1
#endif
#ifndef REPEAT_MASK
#define REPEAT_MASK 0
#endif
#define REP(bit) for (int rep_ = 0; rep_ < ((REPEAT_MASK & (bit)) ? 2 : 1); ++rep_)
constexpr size_t MiB = 1u << 20;
constexpr size_t WS_CTL = 0, CTL_ZERO_BYTES = 64 * 1024;
constexpr size_t WS_MOD = 1 * MiB;
constexpr size_t WS_WIN = 2 * MiB;
constexpr size_t WS_WOUT = 114 * MiB;
constexpr size_t WS_HN = 146 * MiB;
constexpr size_t WS_PROJ = 178 * MiB;
constexpr size_t WS_Y = 290 * MiB;
constexpr size_t WS_X = 322 * MiB;
constexpr size_t WS_RET = 386 * MiB;
constexpr size_t WS_END = 482 * MiB;
constexpr int CW_BAR = 1024;
static_assert((CW_BAR + XCD_BAR_WORDS) * 4 <= (int)CTL_ZERO_BYTES, "CTL");
constexpr int RING_BYTES = 131072, MISC_OFF = RING_BYTES + 320, LDS_BYTES = 147456;

__device__ __forceinline__ float bf2f(unsigned u) { return __uint_as_float(u << 16); }
__device__ __forceinline__ float silu_f(float v) { return v / (1.0f + __expf(-v)); }
__device__ __forceinline__ float wave_sum(float v) {
#pragma unroll
    for (int o = 1; o < 64; o <<= 1) v += __shfl_xor(v, o);
    return v;
}
__device__ __forceinline__ float wave_max(float v) {
#pragma unroll
    for (int o = 1; o < 64; o <<= 1) v = fmaxf(v, __shfl_xor(v, o));
    return v;
}

__device__ __forceinline__ void p0_gemv(const float* c, const float* w_ada, const float* b_ada, float* MOD, LAS unsigned char* lds, int g, int tid) {
    const int wave = tid >> 6, lane = tid & 63, rs = lane >> 3, cgp = lane & 7;
    const int l = g >> 6, col0 = (g & 63) * 96;
    const float* W = w_ada + (size_t)l * D * MODW + col0 + cgp * 12;
    float a0[12], a1[12];
#pragma unroll
    for (int j = 0; j < 12; ++j) { a0[j] = 0.f; a1[j] = 0.f; }
#pragma unroll 4
    for (int it = 0; it < 32; ++it) {
        const int k = wave * 256 + it * 8 + rs;
        const float s0 = silu_f(c[k]), s1 = silu_f(c[D + k]);
        const f32x4* wp = (const f32x4*)(W + (size_t)k * MODW);
        const f32x4 w0 = wp[0], w1 = wp[1], w2 = wp[2];
#pragma unroll
        for (int j = 0; j < 4; ++j) { a0[j] += s0 * w0[j]; a0[4 + j] += s0 * w1[j]; a0[8 + j] += s0 * w2[j]; a1[j] += s1 * w0[j]; a1[4 + j] += s1 * w1[j]; a1[8 + j] += s1 * w2[j]; }
    }
#pragma unroll
    for (int j = 0; j < 12; ++j) {
        a0[j] += __shfl_xor(a0[j], 8); a0[j] += __shfl_xor(a0[j], 16); a0[j] += __shfl_xor(a0[j], 32);
        a1[j] += __shfl_xor(a1[j], 8); a1[j] += __shfl_xor(a1[j], 16); a1[j] += __shfl_xor(a1[j], 32);
    }
    LAS float* red = (LAS float*)lds;
    if (rs == 0) {
#pragma unroll
        for (int j = 0; j < 12; ++j) { red[(wave * 2 + 0) * 96 + cgp * 12 + j] = a0[j]; red[(wave * 2 + 1) * 96 + cgp * 12 + j] = a1[j]; }
    }
    __syncthreads();
    if (tid < 192) { const int b = tid / 96, j = tid % 96; float s = b_ada[l * MODW + col0 + j];
#pragma unroll
        for (int w = 0; w < 8; ++w) s += red[(w * 2 + b) * 96 + j];
        MOD[(size_t)(l * 2 + b) * MODW + col0 + j] = s; }
    __syncthreads();
}
__device__ __forceinline__ void p0_transpose_item(const float* W, int K, int N, bf16* WT, int item, int lane) {
    const int nblk = N / 64, kb = item / nblk, nb = item % nblk, k0 = 64 * kb, n0 = 64 * nb, li = lane & 15, g = lane >> 4;
    f32x4 v[2][8];
#pragma unroll
    for (int hh = 0; hh < 2; ++hh)
#pragma unroll
        for (int r = 0; r < 8; ++r) v[hh][r] = *(const f32x4*)(W + (size_t)(k0 + 32 * hh + 8 * g + r) * N + n0 + 4 * li);
#pragma unroll
    for (int q = 0; q < 4; ++q)
#pragma unroll
        for (int hh = 0; hh < 2; ++hh) { v4u o; o.x = pk2(v[hh][0][q], v[hh][1][q]); o.y = pk2(v[hh][2][q], v[hh][3][q]); o.z = pk2(v[hh][4][q], v[hh][5][q]); o.w = pk2(v[hh][6][q], v[hh][7][q]);
            *(v4u*)(WT + (size_t)(n0 + 4 * li + q) * K + k0 + 32 * hh + 8 * g) = o; }
}
__device__ __forceinline__ void p0_transposes(const float* w_in, const float* w_out, bf16* WIN_T, bf16* WOUT_T, int l, int gw, int NGW, int lane) {
    constexpr int I_IN = (D / 64) * (NP / 64), I_OUT = (D / 64) * (D / 64), I_L = I_IN + I_OUT;
    for (int r = gw; r < I_L; r += NGW) {
        if (r < I_IN) p0_transpose_item(w_in + (size_t)l * D * NP, D, NP, WIN_T + (size_t)l * NP * D, r, lane);
        else p0_transpose_item(w_out + (size_t)l * D * D, D, D, WOUT_T + (size_t)l * D * D, r - I_IN, lane);
    }
}

template <bool FINAL>
__device__ __forceinline__ void norm_rows(const float* src, const float* gain, const float* mod, bf16* outb, float* outf, int gw, int NGW, int lane) {
    for (int m = gw; m < M; m += NGW) {
        const f32x4* xr = (const f32x4*)(src + (size_t)m * D) + lane;
        f32x4 v[8]; float ss = 0.f;
#pragma unroll
        for (int j = 0; j < 8; ++j) { v[j] = xr[64 * j]; ss += (v[j].x * v[j].x + v[j].y * v[j].y) + (v[j].z * v[j].z + v[j].w * v[j].w); }
        const float rstd = rsqrtf(wave_sum(ss) * (1.0f / D) + EPS);
        const int b = m / SEQ;
#pragma unroll
        for (int j = 0; j < 8; ++j) {
            const int col = 4 * (lane + 64 * j);
            const f32x4 g4 = *(const f32x4*)(gain + col);
            f32x4 y = v[j] * rstd * g4;
            if constexpr (FINAL) { *(f32x4*)(outf + (size_t)m * D + col) = y; }
            else {
                const f32x4 sh = *(const f32x4*)(mod + (size_t)b * MODW + col), sc = *(const f32x4*)(mod + (size_t)b * MODW + D + col);
                y = y * (sc + 1.0f) + sh;
                *(unsigned long long*)(outb + (size_t)m * D + col) = (unsigned long long)pk2(y.x, y.y) | ((unsigned long long)pk2(y.z, y.w) << 32);
            }
        }
    }
}

__device__ __forceinline__ void attn_naive(const bf16* PROJ, bf16* Y, LAS unsigned char* lds, int gw, int NGW, int wave, int lane) {
    LAS float* qs = (LAS float*)(lds + wave * 4096);
    LAS float* ps = qs + 128;
    for (int item = gw; item < M * 8; item += NGW) {
        const int m = item >> 3, h = item & 7, b = m / SEQ, t = m % SEQ;
        const float slope = exp2f(-(float)(h + 1));
        { const unsigned qq = *(const unsigned*)(PROJ + (size_t)m * NP + C_QA + h * 128 + 2 * lane); qs[2 * lane] = bf2f(qq & 0xffffu); qs[2 * lane + 1] = bf2f(qq >> 16); }
        LDS_WAIT(); asm volatile("" ::: "memory");
        float sc[7]; float mx = -1e30f;
#pragma unroll
        for (int r = 0; r < 7; ++r) {
            const int i = lane + 64 * r; const int p = i / 129, j = i % 129 - 64; const int dil = (p == 0) ? 1 : ((p == 1) ? 4 : 16);
            const int off = j * dil, s = t + off; const bool valid = (i < 387) && (s >= 0) && (s < SEQ);
            float dot = 0.f;
            if (valid) {
                const bf16* kr = PROJ + (size_t)(b * SEQ + s) * NP + C_KA + h * 128;
#pragma unroll 4
                for (int c8 = 0; c8 < 16; ++c8) { const v4u kk = *(const v4u*)(kr + 8 * c8); const f32x4 q0 = *(const LAS f32x4*)(qs + 8 * c8), q1 = *(const LAS f32x4*)(qs + 8 * c8 + 4);
                    dot += q0.x * bf2f(kk.x & 0xffffu) + q0.y * bf2f(kk.x >> 16) + q0.z * bf2f(kk.y & 0xffffu) + q0.w * bf2f(kk.y >> 16)
                         + q1.x * bf2f(kk.z & 0xffffu) + q1.y * bf2f(kk.z >> 16) + q1.z * bf2f(kk.w & 0xffffu) + q1.w * bf2f(kk.w >> 16); }
            }
            sc[r] = valid ? dot - slope * 1.4426950408889634f * fabsf((float)off) : -1e30f;
            mx = fmaxf(mx, sc[r]);
        }
        mx = wave_max(mx);
        float lsum = 0.f;
#pragma unroll
        for (int r = 0; r < 7; ++r) { const float pr = exp2f(sc[r] - mx); lsum += pr; ps[lane + 64 * r] = pr; }
        lsum = wave_sum(lsum);
        LDS_WAIT(); asm volatile("" ::: "memory");
        float o0 = 0.f, o1 = 0.f;
        for (int p = 0; p < 3; ++p) { const int dil = (p == 0) ? 1 : ((p == 1) ? 4 : 16);
#pragma unroll 8
            for (int jj = 0; jj < 129; ++jj) { int s = t + (jj - 64) * dil; s = s < 0 ? 0 : (s >= SEQ ? SEQ - 1 : s);
                const float pv = ps[p * 129 + jj];
                const unsigned vv = *(const unsigned*)(PROJ + (size_t)(b * SEQ + s) * NP + C_VA + h * 128 + 2 * lane);
                o0 += pv * bf2f(vv & 0xffffu); o1 += pv * bf2f(vv >> 16); } }
        const unsigned zz = *(const unsigned*)(PROJ + (size_t)m * NP + C_ZA + h * 128 + 2 * lane);
        const float inv = 1.0f / lsum;
        *(unsigned*)(Y + (size_t)m * D + h * 128 + 2 * lane) = pk2(o0 * inv * silu_f(bf2f(zz & 0xffffu)), o1 * inv * silu_f(bf2f(zz >> 16)));
        LDS_WAIT(); asm volatile("" ::: "memory");
    }
}

typedef short v4i16_t __attribute__((ext_vector_type(4)));
__device__ __forceinline__ unsigned pkbf(float lo, float hi) { unsigned r; asm("v_cvt_pk_bf16_f32 %0, %1, %2" : "=v"(r) : "v"(lo), "v"(hi)); return r; }
__device__ __forceinline__ void att_kload(bf16x8 (&kf)[2][4], const bf16* Kb, int sbase, int d, int u0, int lane) {
    asm volatile("" : "+v"(lane));
    const int g = lane >> 4, li = lane & 15;
#pragma unroll
    for (int tt = 0; tt < 2; ++tt) { int s = sbase + d * (u0 + 16 * tt + li); s = s < 0 ? 0 : (s >= SEQ ? SEQ - 1 : s);
#pragma unroll
        for (int ks = 0; ks < 4; ++ks) kf[tt][ks] = *(const bf16x8*)(Kb + (size_t)s * NP + 32 * ks + 8 * g); }
}
__device__ __forceinline__ void att_vload(v4u (&vr)[8], const bf16* Vb, int sbase, int d, int u0, int lane) {
    asm volatile("" : "+v"(lane));
    const int g = lane >> 4, li = lane & 15;
#pragma unroll
    for (int it = 0; it < 8; ++it) { int s = sbase + d * (u0 + 4 * it + g); s = s < 0 ? 0 : (s >= SEQ ? SEQ - 1 : s); vr[it] = *(const v4u*)(Vb + (size_t)s * NP + 8 * li); }
}
template <int NQ, int Q0, int PAT>
__device__ __forceinline__ void att_body(const bf16x8 (&kf)[2][4], v4u (&vr)[8], const bf16* Vb, int sbase, int u0, int nsbase, int nd, int nu0, float slope, f32x4 (&O)[2][8], float (&mrun)[2], float (&lrun)[2],
                                         const int (&rq)[2], LAS unsigned char* vbuf, int lane) {
    constexpr int d = (PAT == 0) ? 1 : ((PAT == 1) ? 4 : 16);
    asm volatile("" : "+v"(lane));
    const int g = lane >> 4, li = lane & 15;
    const float nslope_d = slope * (float)d * 1.4426950408889634f;
    __builtin_amdgcn_sched_barrier(0);
#pragma unroll
    for (int it = 0; it < 8; ++it) { const int row = 4 * it + g; *(LAS v4u*)(vbuf + row * 256 + ((((li >> 1) ^ (row & 7))) << 5) + ((li & 1) << 4)) = vr[it]; }
    if (nd > 0) att_vload(vr, Vb, nsbase, nd, nu0, lane);
    __builtin_amdgcn_sched_barrier(0);
    bf16x8 qf[2][4];
#pragma unroll
    for (int q = 0; q < NQ; ++q)
#pragma unroll
        for (int ks = 0; ks < 4; ++ks) qf[Q0 + q][ks] = *(const LAS bf16x8*)(vbuf + 8192 + (((Q0 + q) * 4 + ks) * 64 + lane) * 16);
    f32x4 sacc[NQ][2];
#pragma unroll
    for (int q = 0; q < NQ; ++q)
#pragma unroll
        for (int tt = 0; tt < 2; ++tt) { sacc[q][tt] = (f32x4){0.f, 0.f, 0.f, 0.f};
#pragma unroll
            for (int ks = 0; ks < 4; ++ks) sacc[q][tt] = __builtin_amdgcn_mfma_f32_16x16x32_bf16(kf[tt][ks], qf[Q0 + q][ks], sacc[q][tt], 0, 0, 0); }
    bf16x8 pf[NQ];
    const bool edge = (sbase + d * u0 < 0) || (sbase + d * (u0 + 31) >= SEQ);
#pragma unroll
    for (int q = 0; q < NQ; ++q) {
        const int qi = (PAT == 0) ? (16 * li + rq[Q0 + q]) : ((PAT == 1) ? (4 * li + (rq[Q0 + q] >> 2)) : li);
        const float jb = (float)(4 * g - qi);
        float sv[8]; float mt = -INFINITY;
#pragma unroll
        for (int tt = 0; tt < 2; ++tt)
#pragma unroll
            for (int rg = 0; rg < 4; ++rg) { const float jf = jb + (float)(u0 + 16 * tt + rg);
                const float x = __builtin_fmaf(-__builtin_fabsf(jf), nslope_d, sacc[q][tt][rg]);
                bool ok = __builtin_fabsf(jf) <= 64.0f;
                if (edge) { const int s = sbase + d * (u0 + 16 * tt + 4 * g + rg); ok = ok && (s >= 0) && (s < SEQ); }
                sv[4 * tt + rg] = ok ? x : -INFINITY; mt = fmaxf(mt, sv[4 * tt + rg]); }
        mt = fmaxf(mt, __shfl_xor(mt, 16)); mt = fmaxf(mt, __shfl_xor(mt, 32));
        const float mnew = fmaxf(mrun[Q0 + q], mt);
        if (!__all(mnew == mrun[Q0 + q])) { const float alpha = __builtin_amdgcn_exp2f(mrun[Q0 + q] - mnew); mrun[Q0 + q] = mnew; lrun[Q0 + q] *= alpha;
#pragma unroll
            for (int dt = 0; dt < 8; ++dt) O[Q0 + q][dt] = O[Q0 + q][dt] * alpha; }
        float p[8], psum = 0.f;
#pragma unroll
        for (int e = 0; e < 8; ++e) { p[e] = __builtin_amdgcn_exp2f(sv[e] - mnew); psum += p[e]; }
        lrun[Q0 + q] += psum;
        v4u pw; pw.x = pkbf(p[0], p[1]); pw.y = pkbf(p[2], p[3]); pw.z = pkbf(p[4], p[5]); pw.w = pkbf(p[6], p[7]);
        pf[q] = __builtin_bit_cast(bf16x8, pw);
    }
    const int qq = li >> 2, pp = li & 3;
#pragma unroll
    for (int dt = 0; dt < 8; ++dt) {
        const int r0 = 4 * g + qq, r1 = 16 + 4 * g + qq;
        const v4i16_t a0 = __builtin_amdgcn_ds_read_tr16_b64_v4i16((LAS v4i16_t*)(vbuf + r0 * 256 + ((dt ^ (r0 & 7)) << 5) + 8 * pp));
        const v4i16_t a1 = __builtin_amdgcn_ds_read_tr16_b64_v4i16((LAS v4i16_t*)(vbuf + r1 * 256 + ((dt ^ (r1 & 7)) << 5) + 8 * pp));
        bf16x8 af; af[0] = a0[0]; af[1] = a0[1]; af[2] = a0[2]; af[3] = a0[3]; af[4] = a1[0]; af[5] = a1[1]; af[6] = a1[2]; af[7] = a1[3];
#pragma unroll
        for (int q = 0; q < NQ; ++q) O[Q0 + q][dt] = __builtin_amdgcn_mfma_f32_16x16x32_bf16(af, pf[q], O[Q0 + q][dt], 0, 0, 0);
    }
    __builtin_amdgcn_sched_barrier(0);
}
__device__ __forceinline__ void attn_unit(const bf16* PROJ, bf16* Y, int unit, LAS unsigned char* vbuf, int wave, int lane) {
    const int blk = unit & 15, h = (unit >> 4) & 7, b = unit >> 7, T0 = blk * 256;
    const int g = lane >> 4, li = lane & 15;
    const bf16* Pb = PROJ + (size_t)b * SEQ * NP;
    const bf16* Kb = Pb + C_KA + h * 128; const bf16* Vb = Pb + C_VA + h * 128;
    const float slope = exp2f(-(float)(h + 1));
    int rq[2]; rq[0] = wave; rq[1] = wave + 8;
    f32x4 O[2][8]; float mrun[2], lrun[2];
#pragma unroll
    for (int q = 0; q < 2; ++q) { const int tq = T0 + 16 * li + rq[q];
#pragma unroll
        for (int ks = 0; ks < 4; ++ks) *(LAS bf16x8*)(vbuf + 8192 + ((q * 4 + ks) * 64 + lane) * 16) = *(const bf16x8*)(Pb + (size_t)tq * NP + C_QA + h * 128 + 32 * ks + 8 * g);
#pragma unroll
        for (int dt = 0; dt < 8; ++dt) O[q][dt] = (f32x4){0.f, 0.f, 0.f, 0.f};
        mrun[q] = -1e30f; lrun[q] = 0.f; }
    bf16x8 kfa[2][4], kfb[2][4]; v4u vr[8];
    const int sb4 = T0 + (wave & 3), sb16a = T0 + rq[0], sb16b = T0 + rq[1];
    att_kload(kfa, Kb, T0, 1, -64, lane); att_vload(vr, Vb, T0, 1, -64, lane);
#pragma unroll 1
    for (int pi = 0; pi < 12; pi += 2) {
        att_kload(kfb, Kb, T0, 1, -64 + 32 * (pi + 1), lane);
        att_body<2, 0, 0>(kfa, vr, Vb, T0, -64 + 32 * pi, T0, 1, -64 + 32 * (pi + 1), slope, O, mrun, lrun, rq, vbuf, lane);
        const bool more = pi + 2 < 12;
        if (more) att_kload(kfa, Kb, T0, 1, -64 + 32 * (pi + 2), lane); else att_kload(kfa, Kb, sb4, 4, -64, lane);
        att_body<2, 0, 0>(kfb, vr, Vb, T0, -64 + 32 * (pi + 1), more ? T0 : sb4, more ? 1 : 4, more ? -64 + 32 * (pi + 2) : -64, slope, O, mrun, lrun, rq, vbuf, lane);
    }
#pragma unroll 1
    for (int pi = 0; pi < 6; pi += 2) {
        att_kload(kfb, Kb, sb4, 4, -64 + 32 * (pi + 1), lane);
        att_body<2, 0, 1>(kfa, vr, Vb, sb4, -64 + 32 * pi, sb4, 4, -64 + 32 * (pi + 1), slope, O, mrun, lrun, rq, vbuf, lane);
        const bool more = pi + 2 < 6;
        if (more) att_kload(kfa, Kb, sb4, 4, -64 + 32 * (pi + 2), lane); else att_kload(kfa, Kb, sb16a, 16, -64, lane);
        att_body<2, 0, 1>(kfb, vr, Vb, sb4, -64 + 32 * (pi + 1), more ? sb4 : sb16a, more ? 4 : 16, more ? -64 + 32 * (pi + 2) : -64, slope, O, mrun, lrun, rq, vbuf, lane);
    }
    att_kload(kfb, Kb, sb16a, 16, -32, lane);  att_body<1, 0, 2>(kfa, vr, Vb, sb16a, -64, sb16a, 16, -32, slope, O, mrun, lrun, rq, vbuf, lane);
    att_kload(kfa, Kb, sb16a, 16, 0, lane);    att_body<1, 0, 2>(kfb, vr, Vb, sb16a, -32, sb16a, 16, 0, slope, O, mrun, lrun, rq, vbuf, lane);
    att_kload(kfb, Kb, sb16a, 16, 32, lane);   att_body<1, 0, 2>(kfa, vr, Vb, sb16a, 0, sb16a, 16, 32, slope, O, mrun, lrun, rq, vbuf, lane);
    att_kload(kfa, Kb, sb16a, 16, 64, lane);   att_body<1, 0, 2>(kfb, vr, Vb, sb16a, 32, sb16a, 16, 64, slope, O, mrun, lrun, rq, vbuf, lane);
    att_kload(kfb, Kb, sb16b, 16, -64, lane);  att_body<1, 0, 2>(kfa, vr, Vb, sb16a, 64, sb16b, 16, -64, slope, O, mrun, lrun, rq, vbuf, lane);
    att_kload(kfa, Kb, sb16b, 16, -32, lane);  att_body<1, 1, 2>(kfb, vr, Vb, sb16b, -64, sb16b, 16, -32, slope, O, mrun, lrun, rq, vbuf, lane);
    att_kload(kfb, Kb, sb16b, 16, 0, lane);    att_body<1, 1, 2>(kfa, vr, Vb, sb16b, -32, sb16b, 16, 0, slope, O, mrun, lrun, rq, vbuf, lane);
    att_kload(kfa, Kb, sb16b, 16, 32, lane);   att_body<1, 1, 2>(kfb, vr, Vb, sb16b, 0, sb16b, 16, 32, slope, O, mrun, lrun, rq, vbuf, lane);
    att_kload(kfb, Kb, sb16b, 16, 64, lane);   att_body<1, 1, 2>(kfa, vr, Vb, sb16b, 32, sb16b, 16, 64, slope, O, mrun, lrun, rq, vbuf, lane);
    att_body<1, 1, 2>(kfb, vr, Vb, sb16b, 64, 0, 0, 0, slope, O, mrun, lrun, rq, vbuf, lane);
#pragma unroll
    for (int q = 0; q < 2; ++q) { float l = lrun[q]; l += __shfl_xor(l, 16); l += __shfl_xor(l, 32); const float inv = 1.0f / l;
        const size_t tok = (size_t)b * SEQ + T0 + 16 * li + rq[q];
#pragma unroll
        for (int dt = 0; dt < 8; ++dt) { const int col = h * 128 + 16 * dt + 4 * g;
            const unsigned long long zz = *(const unsigned long long*)(PROJ + tok * NP + C_ZA + col); const unsigned z0 = (unsigned)zz, z1 = (unsigned)(zz >> 32);
            const f32x4 o = O[q][dt] * inv;
            *(unsigned long long*)(Y + tok * D + col) = (unsigned long long)pk2(o[0] * silu_f(bf2f(z0 & 0xffffu)), o[1] * silu_f(bf2f(z0 >> 16)))
                | ((unsigned long long)pk2(o[2] * silu_f(bf2f(z1 & 0xffffu)), o[3] * silu_f(bf2f(z1 >> 16))) << 32); } }
}

constexpr int LDT = 136;
__device__ __forceinline__ float log2_gamma(float logit) { return -log1pf(__expf(-logit)) * 1.4426950408889634f; }
template <int NT, int KSTEPS>
__device__ __forceinline__ void mma_lds(f32x4 (&acc)[NT], const LAS bf16* A, int lda, int arow0, const LAS bf16* Bt, int ldb, int bcol0, int lane) {
    const int g = lane >> 4, li = lane & 15;
#pragma unroll
    for (int ks = 0; ks < KSTEPS; ++ks) { const bf16x8 a = *(const LAS bf16x8*)(A + (arow0 + li) * lda + 32 * ks + 8 * g);
#pragma unroll
        for (int nt = 0; nt < NT; ++nt) { const bf16x8 b = *(const LAS bf16x8*)(Bt + (bcol0 + 16 * nt + li) * ldb + 32 * ks + 8 * g); acc[nt] = __builtin_amdgcn_mfma_f32_16x16x32_bf16(a, b, acc[nt], 0, 0, 0);
            if ((nt & 7) == 7) __builtin_amdgcn_sched_barrier(0); } }
}
template <int NCH  , bool SCALE>
__device__ __forceinline__ void stage_T(const bf16* src, LAS bf16* dst, int tid, float zs, float zb, float zm) {
    const int j = tid & 127, cg0 = tid >> 7;
    float sc = 1.f; if (SCALE) sc = exp2f(zs * (zb + zm * (float)j));
#pragma unroll
    for (int it = 0; it < NCH; ++it) { const int c = cg0 + 4 * it; const v4u w = *(const v4u*)(src + (size_t)j * NP + 8 * c);
        unsigned short e[8]; e[0] = w.x & 0xffffu; e[1] = w.x >> 16; e[2] = w.y & 0xffffu; e[3] = w.y >> 16; e[4] = w.z & 0xffffu; e[5] = w.z >> 16; e[6] = w.w & 0xffffu; e[7] = w.w >> 16;
#pragma unroll
        for (int q = 0; q < 8; ++q) dst[(8 * c + q) * LDT + j] = SCALE ? (bf16)f2bf(bf2f(e[q]) * sc) : (bf16)e[q]; }
}
template <int NROWS, bool SCALE>
__device__ __forceinline__ void stage_N(const bf16* src, int ld, LAS bf16* dst, int tid, float zs, float zb, float zm) {
#pragma unroll
    for (int it = 0; it < NROWS * 16 / 512; ++it) { const int idx = tid + 512 * it, row = idx >> 4, c = idx & 15; v4u w = *(const v4u*)(src + (size_t)row * ld + 8 * c);
        if (SCALE) { const float sc = exp2f(zs * (zb + zm * (float)row));
            w.x = pk2(bf2f(w.x & 0xffffu) * sc, bf2f(w.x >> 16) * sc); w.y = pk2(bf2f(w.y & 0xffffu) * sc, bf2f(w.y >> 16) * sc);
            w.z = pk2(bf2f(w.z & 0xffffu) * sc, bf2f(w.z >> 16) * sc); w.w = pk2(bf2f(w.w & 0xffffu) * sc, bf2f(w.w >> 16) * sc); }
        *(LAS v4u*)(dst + row * LDT + 8 * c) = w; }
}
__device__ __forceinline__ int swz(int row) { return (row & 3) | (((row >> 3) & 1) << 2); }
__device__ __forceinline__ int img_off(int row, int c16, int rowb) { return row * rowb + ((((c16 >> 1) ^ swz(row))) << 5) + ((c16 & 1) << 4); }
__device__ __forceinline__ bf16x8 frag_tr(const LAS unsigned char* img, int rowb, int k0, int col0, int lane) {
    const int g = lane >> 4, q = (lane >> 2) & 3, p = lane & 3, r0 = k0 + 8 * g + q, cb = (col0 + 4 * p) * 2;
    const int o0 = r0 * rowb + ((((cb >> 5) ^ swz(r0))) << 5) + (cb & 31);
    const v4i16_t a0 = __builtin_amdgcn_ds_read_tr16_b64_v4i16((LAS v4i16_t*)(img + o0));
    const v4i16_t a1 = __builtin_amdgcn_ds_read_tr16_b64_v4i16((LAS v4i16_t*)(img + o0 + 4 * rowb));
    bf16x8 f; f[0] = a0[0]; f[1] = a0[1]; f[2] = a0[2]; f[3] = a0[3]; f[4] = a1[0]; f[5] = a1[1]; f[6] = a1[2]; f[7] = a1[3]; return f;
}
__device__ __forceinline__ v4u scale8(v4u w, float sc) {
    w.x = pk2(bf2f(w.x & 0xffffu) * sc, bf2f(w.x >> 16) * sc); w.y = pk2(bf2f(w.y & 0xffffu) * sc, bf2f(w.y >> 16) * sc);
    w.z = pk2(bf2f(w.z & 0xffffu) * sc, bf2f(w.z >> 16) * sc); w.w = pk2(bf2f(w.w & 0xffffu) * sc, bf2f(w.w >> 16) * sc); return w;
}
__device__ __forceinline__ void ret_chunk_state(const bf16* PROJ, const float* dec_f, const float* dec_b, float* KV, LAS unsigned char* lds, int unit, int tid) {
    asm volatile("" : "+v"(tid));
    const int n = unit & 31, h = (unit >> 5) & 3, b = unit >> 7, lane = tid & 63, wave = __builtin_amdgcn_readfirstlane(tid >> 6), g = lane >> 4, li = lane & 15;
    LAS unsigned char* Vimg = lds; LAS unsigned char* Kimg = lds + 65536;
    const bf16* rowp = PROJ + (size_t)(b * SEQ + n * 128) * NP;
    const float lf2 = log2_gamma(dec_f[h]), lb2 = log2_gamma(dec_b[h]);
    v4u kq[4], vq[8];
#pragma unroll
    for (int it = 0; it < 4; ++it) { const int idx = tid + 512 * it; kq[it] = *(const v4u*)(rowp + (size_t)(idx >> 4) * NP + C_KR + h * 128 + 8 * (idx & 15)); }
#pragma unroll
    for (int it = 0; it < 8; ++it) { const int idx = tid + 512 * it; vq[it] = *(const v4u*)(rowp + (size_t)(idx >> 5) * NP + C_VR + h * 256 + 8 * (idx & 31)); }
#pragma unroll
    for (int it = 0; it < 8; ++it) { const int idx = tid + 512 * it; *(LAS v4u*)(Vimg + img_off(idx >> 5, idx & 31, 512)) = vq[it]; }
#pragma unroll 1
    for (int dir = 0; dir < 2; ++dir) {
#pragma unroll
        for (int it = 0; it < 4; ++it) { const int idx = tid + 512 * it, j = idx >> 4;
            const float z = dir ? exp2f(lb2 * (float)j) : exp2f(lf2 * (float)(127 - j));
            *(LAS v4u*)(Kimg + img_off(j, idx & 15, 256)) = scale8(kq[it], z); }
        __syncthreads();
        f32x4 acc[16];
#pragma unroll
        for (int nt = 0; nt < 16; ++nt) acc[nt] = (f32x4){0.f, 0.f, 0.f, 0.f};
#pragma unroll
        for (int ks = 0; ks < 4; ++ks) { const bf16x8 a = frag_tr(Kimg, 256, 32 * ks, 16 * wave, lane);
#pragma unroll
            for (int nt = 0; nt < 16; ++nt) { acc[nt] = __builtin_amdgcn_mfma_f32_16x16x32_bf16(a, frag_tr(Vimg, 512, 32 * ks, 16 * nt, lane), acc[nt], 0, 0, 0);
                if ((nt & 3) == 3) __builtin_amdgcn_sched_barrier(0); } }
        float* out = KV + ((size_t)(((dir * 2 + b) * 4 + h) * 32 + n)) * 32768;
#pragma unroll
        for (int nt = 0; nt < 16; ++nt) *(f32x4*)(out + (16 * nt + li) * 128 + 16 * wave + 4 * g) = acc[nt];
        __syncthreads();
    }
}
__device__ __forceinline__ void ret_scan(const float* KV, bf16* Sbf, const float* dec_f, const float* dec_b, int gt) {
    const int seq = gt >> 13, e4 = gt & 8191, dir = seq >> 3, h = seq & 3;
    const float gch = exp2f(128.f * log2_gamma(dir ? dec_b[h] : dec_f[h]));
    const float* kv = KV + (size_t)seq * 32 * 32768 + 4 * e4; bf16* sb = Sbf + (size_t)seq * 32 * 32768 + 4 * e4;
    f32x4 S = (f32x4){0.f, 0.f, 0.f, 0.f};
#pragma unroll 1
    for (int n0 = 0; n0 < 32; n0 += 8) {
        f32x4 v[8];
#pragma unroll
        for (int i = 0; i < 8; ++i) { const int n = dir ? 31 - (n0 + i) : n0 + i; v[i] = *(const f32x4*)(kv + (size_t)n * 32768); }
#pragma unroll
        for (int i = 0; i < 8; ++i) { const int n = dir ? 31 - (n0 + i) : n0 + i;
            *(unsigned long long*)(sb + (size_t)n * 32768) = (unsigned long long)pk2(S.x, S.y) | ((unsigned long long)pk2(S.z, S.w) << 32);
            S = S * gch + v[i]; }
    }
}
__device__ __forceinline__ void ret_output(const bf16* PROJ, const bf16* Sbf, const float* dec_f, const float* dec_b, bf16* Y, LAS unsigned char* lds, int unit, int tid) {
    asm volatile("" : "+v"(tid));
    const int n = unit & 31, h = (unit >> 5) & 3, b = unit >> 7, lane = tid & 63, wave = __builtin_amdgcn_readfirstlane(tid >> 6), g = lane >> 4, li = lane & 15;
    LAS bf16* bufA = (LAS bf16*)lds; LAS bf16* bufC = bufA + 128 * LDT; LAS unsigned char* Vimg = lds + 128 * LDT * 2;
    const bf16* rowp = PROJ + (size_t)(b * SEQ + n * 128) * NP;
    const float lf2 = log2_gamma(dec_f[h]), lb2 = log2_gamma(dec_b[h]);
    v4u q4[4], pre[8];
#pragma unroll
    for (int it = 0; it < 4; ++it) { const int idx = tid + 512 * it; q4[it] = *(const v4u*)(rowp + (size_t)(idx >> 4) * NP + C_QR + h * 128 + 8 * (idx & 15)); }
#pragma unroll
    for (int it = 0; it < 4; ++it) { const int idx = tid + 512 * it; pre[it] = *(const v4u*)(rowp + (size_t)(idx >> 4) * NP + C_KR + h * 128 + 8 * (idx & 15)); }
#pragma unroll
    for (int it = 0; it < 4; ++it) { const int idx = tid + 512 * it; *(LAS v4u*)(bufA + (idx >> 4) * LDT + 8 * (idx & 15)) = q4[it]; *(LAS v4u*)(bufC + (idx >> 4) * LDT + 8 * (idx & 15)) = pre[it]; }
#pragma unroll
    for (int it = 0; it < 8; ++it) { const int idx = tid + 512 * it; pre[it] = *(const v4u*)(rowp + (size_t)(idx >> 5) * NP + C_VR + h * 256 + 8 * (idx & 31)); }
    __syncthreads();
    f32x4 sc[8];
#pragma unroll
    for (int nt = 0; nt < 8; ++nt) sc[nt] = (f32x4){0.f, 0.f, 0.f, 0.f};
    mma_lds<8, 4>(sc, bufA, LDT, 16 * wave, bufC, LDT, 0, lane);
    __syncthreads();
#pragma unroll
    for (int nt = 0; nt < 8; ++nt)
#pragma unroll
        for (int rg = 0; rg < 4; ++rg) { const int i = 16 * wave + 4 * g + rg, j = 16 * nt + li; const int dd = i - j;
            const float dm = (dd == 0) ? 2.0f : (dd > 0 ? exp2f(lf2 * (float)dd) : exp2f(lb2 * (float)(-dd)));
            bufA[i * LDT + j] = (bf16)f2bf(sc[nt][rg] * dm); }
#pragma unroll
    for (int it = 0; it < 8; ++it) { const int idx = tid + 512 * it; *(LAS v4u*)(Vimg + img_off(idx >> 5, idx & 31, 512)) = pre[it]; }
    const bf16* Sf = Sbf + ((size_t)(((0 * 2 + b) * 4 + h) * 32 + n)) * 32768; const bf16* Sb = Sbf + ((size_t)(((1 * 2 + b) * 4 + h) * 32 + n)) * 32768;
#pragma unroll
    for (int it = 0; it < 8; ++it) { const int idx = tid + 512 * it; pre[it] = *(const v4u*)(Sf + (size_t)(idx >> 4) * 128 + 8 * (idx & 15)); }
    __syncthreads();
    f32x4 acc[16];
#pragma unroll
    for (int nt = 0; nt < 16; ++nt) acc[nt] = (f32x4){0.f, 0.f, 0.f, 0.f};
#pragma unroll
    for (int ks = 0; ks < 4; ++ks) { const bf16x8 a = *(const LAS bf16x8*)(bufA + (16 * wave + li) * LDT + 32 * ks + 8 * g);
#pragma unroll
        for (int nt = 0; nt < 16; ++nt) { acc[nt] = __builtin_amdgcn_mfma_f32_16x16x32_bf16(a, frag_tr(Vimg, 512, 32 * ks, 16 * nt, lane), acc[nt], 0, 0, 0);
            if ((nt & 3) == 3) __builtin_amdgcn_sched_barrier(0); } }
    __syncthreads();
#pragma unroll 1
    for (int dir = 0; dir < 2; ++dir) {
#pragma unroll
        for (int it = 0; it < 4; ++it) { const int idx = tid + 512 * it, i = idx >> 4;
            const float xi = dir ? exp2f(lb2 * (float)(128 - i)) : exp2f(lf2 * (float)(i + 1));
            *(LAS v4u*)(bufA + i * LDT + 8 * (idx & 15)) = scale8(q4[it], xi); }
#pragma unroll
        for (int it = 0; it < 8; ++it) { const int idx = tid + 512 * it; *(LAS v4u*)(bufC + (idx >> 4) * LDT + 8 * (idx & 15)) = pre[it]; }
        if (dir == 0) {
#pragma unroll
            for (int it = 0; it < 8; ++it) { const int idx = tid + 512 * it; pre[it] = *(const v4u*)(Sb + (size_t)(idx >> 4) * 128 + 8 * (idx & 15)); } }
        else {
#pragma unroll
            for (int it = 0; it < 8; ++it) { const int idx = tid + 512 * it; pre[it] = *(const v4u*)(rowp + (size_t)(idx >> 5) * NP + C_ZR + h * 256 + 8 * (idx & 31)); } }
        __syncthreads();
        mma_lds<16, 4>(acc, bufA, LDT, 16 * wave, bufC, LDT, 0, lane);
        __syncthreads();
    }
    constexpr int LDZ = 264;
    LAS bf16* zb = (LAS bf16*)lds;
#pragma unroll
    for (int it = 0; it < 8; ++it) { const int idx = tid + 512 * it; *(LAS v4u*)(zb + (idx >> 5) * LDZ + 8 * (idx & 31)) = pre[it]; }
    float rn[4];
#pragma unroll
    for (int rg = 0; rg < 4; ++rg) { float ss = 0.f;
#pragma unroll
        for (int nt = 0; nt < 16; ++nt) ss += acc[nt][rg] * acc[nt][rg];
        ss += __shfl_xor(ss, 1); ss += __shfl_xor(ss, 2); ss += __shfl_xor(ss, 4); ss += __shfl_xor(ss, 8);
        rn[rg] = rsqrtf(ss * (1.0f / 256.0f) + EPS); }
    __syncthreads();
#pragma unroll
    for (int nt = 0; nt < 16; ++nt)
#pragma unroll
        for (int rg = 0; rg < 4; ++rg) { LAS bf16* p = zb + (16 * wave + 4 * g + rg) * LDZ + 16 * nt + li; *p = (bf16)f2bf(acc[nt][rg] * rn[rg] * silu_f(bf2f(*p))); }
    __syncthreads();
    bf16* yrow = Y + (size_t)(b * SEQ + n * 128) * D + 1024 + h * 256;
#pragma unroll
    for (int it = 0; it < 8; ++it) { const int idx = tid + 512 * it, row = idx >> 5, c = idx & 31; *(v4u*)(yrow + (size_t)row * D + 8 * c) = *(const LAS v4u*)(zb + row * LDZ + 8 * c); }
    __syncthreads();
}

__device__ __forceinline__ void ret_naive_scan(const bf16* PROJ, const float* dec_f, const float* dec_b, float* OUT, LAS unsigned char* lds, int unit, int tid) {
    const int dir = unit >> 3, b = (unit >> 2) & 1, h = unit & 3;
    const float logit = dir ? dec_b[h] : dec_f[h]; const float gamma = 1.0f / (1.0f + __expf(-logit));
    const int e = tid & 255, half = tid >> 8;
    LAS float* qk = (LAS float*)lds;
    LAS float* red = qk + 512;
    float S[64];
#pragma unroll
    for (int d = 0; d < 64; ++d) S[d] = 0.f;
    const int qkcol = (tid < 128) ? (C_QR + h * 128 + tid) : (C_KR + h * 128 + (tid & 127));
    int t0 = dir ? SEQ - 1 : 0;
    unsigned short nqk = PROJ[(size_t)(b * SEQ + t0) * NP + qkcol], nv = PROJ[(size_t)(b * SEQ + t0) * NP + C_VR + h * 256 + e];
    for (int step = 0; step < SEQ; ++step) {
        const int t = dir ? SEQ - 1 - step : step, m = b * SEQ + t, buf = step & 1;
        if (tid < 256) qk[buf * 256 + tid] = bf2f(nqk);
        const float ve = bf2f(nv);
        if (step + 1 < SEQ) { const int tn = dir ? t - 1 : t + 1; nqk = PROJ[(size_t)(b * SEQ + tn) * NP + qkcol]; nv = PROJ[(size_t)(b * SEQ + tn) * NP + C_VR + h * 256 + e]; }
        __syncthreads();
        float part = 0.f;
        const LAS float* qp = qk + buf * 256 + 64 * half; const LAS float* kp = qp + 128;
#pragma unroll
        for (int d = 0; d < 64; ++d) { S[d] = gamma * S[d] + kp[d] * ve; part += qp[d] * S[d]; }
        if (half == 1) red[buf * 256 + e] = part;
        __syncthreads();
        if (half == 0) OUT[((size_t)dir * M + m) * 1024 + h * 256 + e] = part + red[buf * 256 + e];
    }
}
__device__ __forceinline__ void ret_naive_combine(const float* OUT, const bf16* PROJ, bf16* Y, int gw, int NGW, int lane) {
    for (int item = gw; item < M * 4; item += NGW) {
        const int m = item >> 2, h = item & 3;
        const f32x4 a = *(const f32x4*)(OUT + (size_t)m * 1024 + h * 256 + 4 * lane), bq = *(const f32x4*)(OUT + ((size_t)M + m) * 1024 + h * 256 + 4 * lane);
        const f32x4 o = a + bq;
        const float r = rsqrtf(wave_sum((o.x * o.x + o.y * o.y) + (o.z * o.z + o.w * o.w)) * (1.0f / 256.0f) + EPS);
        const unsigned long long zz = *(const unsigned long long*)(PROJ + (size_t)m * NP + C_ZR + h * 256 + 4 * lane);
        const unsigned z0 = (unsigned)zz, z1 = (unsigned)(zz >> 32);
        const float y0 = o.x * r * silu_f(bf2f(z0 & 0xffffu)), y1 = o.y * r * silu_f(bf2f(z0 >> 16)), y2 = o.z * r * silu_f(bf2f(z1 & 0xffffu)), y3 = o.w * r * silu_f(bf2f(z1 >> 16));
        *(unsigned long long*)(Y + (size_t)m * D + 1024 + h * 256 + 4 * lane) = (unsigned long long)pk2(y0, y1) | ((unsigned long long)pk2(y2, y3) << 32);
    }
}

struct Args { const float* in[10]; float* out; unsigned char* ws; int ph_lo, ph_hi, use_bar, pad; };
constexpr int N_PHASES = 2 + 5 * DEPTH;

__device__ __forceinline__ unsigned lds_word(unsigned byte_off) { asm volatile("" : "+v"(byte_off)); return __builtin_amdgcn_readfirstlane(*(volatile LAS unsigned*)byte_off); }
__device__ __forceinline__ unsigned char* ld_ptr(volatile LAS unsigned* tab, int i) {
    (void)tab;
    const unsigned lo = lds_word(MISC_OFF + 128 + 8 * i), hi = lds_word(MISC_OFF + 128 + 8 * i + 4);
    return (unsigned char*)(((unsigned long long)hi << 32) | lo);
}
__global__ void __launch_bounds__(NWAVES * 64, 2) fwd_kernel(Args args) {
    extern __shared__ __attribute__((aligned(16))) unsigned char lds_raw[];
    LAS unsigned char* lds = (LAS unsigned char*)lds_raw;
    const int tid = threadIdx.x;
    const int wave_s = __builtin_amdgcn_readfirstlane(tid >> 6);
    if ((unsigned)(size_t)lds != 0u) return;
    volatile LAS unsigned* MISC = (volatile LAS unsigned*)(lds + MISC_OFF);
    volatile LAS unsigned* TAB = MISC + 32;
    for (int u = tid; u < (LDS_BYTES - RING_BYTES) / 4; u += NWAVES * 64) ((LAS unsigned*)(lds + RING_BYTES))[u] = 0u;
    __syncthreads();
    if (tid < 12) { const unsigned long long v = (tid < 10) ? (unsigned long long)args.in[tid] : (tid == 10 ? (unsigned long long)args.out : (unsigned long long)args.ws);
        TAB[2 * tid] = (unsigned)v; TAB[2 * tid + 1] = (unsigned)(v >> 32); }
    __syncthreads();
    if (tid == 0) { MISC[11] = (unsigned)args.ph_lo; MISC[12] = (unsigned)args.ph_hi; MISC[13] = (unsigned)args.use_bar; }
    if (args.use_bar) { const XcdBarrier b0 = xcd_barrier_post((unsigned*)(args.ws + WS_CTL) + CW_BAR, MISC + 8); if (tid == 0) MISC[10] = b0.x; }
    __syncthreads();
#define CFG(i) ((int)lds_word(MISC_OFF + 4 * (i)))
#define IN(k) (CFG(11) <= (k) && (k) < CFG(12))
#ifndef BAR_REPS
#define BAR_REPS 1
#endif
#define GRID_BAR() do { if (CFG(13)) for (int br_ = 0; br_ < BAR_REPS; ++br_) { XcdBarrier b_; b_.bar = (unsigned*)(ld_ptr(TAB, 11) + WS_CTL) + CW_BAR; b_.x = (unsigned)CFG(10); b_.st = MISC + 8; xcd_barrier(b_); } } while (0)
#define PTR(i) ld_ptr(TAB, (i))
#define MY_TID() (wave_s * 64 + (int)__builtin_amdgcn_mbcnt_hi(~0u, __builtin_amdgcn_mbcnt_lo(~0u, 0u)))
#define WAVE_IDS() int t__ = MY_TID(); asm volatile("" : "+v"(t__)); const int lane = t__ & 63, wave = __builtin_amdgcn_readfirstlane(t__ >> 6), gw = blockIdx.x * NWAVES + wave, NGW = gridDim.x * NWAVES

    if (IN(0)) {
        WAVE_IDS(); unsigned char* ws = PTR(11);
        REP(64) {
        p0_gemv((const float*)PTR(1), (const float*)PTR(3), (const float*)PTR(4), (float*)(ws + WS_MOD), lds, blockIdx.x, t__);
        p0_transposes((const float*)PTR(5), (const float*)PTR(6), (bf16*)(ws + WS_WIN), (bf16*)(ws + WS_WOUT), 0, gw, NGW, lane);
        __syncthreads(); }
        if (CFG(13)) cg::this_grid().sync();
        GRID_BAR();
    }
    for (int l = 0; l < DEPTH; ++l) {
        const int pb = 1 + 5 * l;
        if (IN(pb + 0)) { WAVE_IDS(); unsigned char* ws = PTR(11);
            REP(1) norm_rows<false>((l == 0) ? (const float*)PTR(0) : (const float*)(ws + WS_X), (const float*)PTR(2) + l * D, (const float*)(ws + WS_MOD) + (size_t)l * 2 * MODW, (bf16*)(ws + WS_HN), nullptr, gw, NGW, lane);
            GRID_BAR(); }
        if (IN(pb + 1)) { unsigned char* ws = PTR(11);
            pg8::Gemm g{(const bf16*)(ws + WS_HN), (const bf16*)(ws + WS_WIN) + (size_t)l * NP * D, M, NP, D}; pg8::StaticOrder S; S.init(M, NP, gridDim.x, blockIdx.x);
            pg8::EpiProj E{(bf16*)(ws + WS_PROJ), NP};
            REP(2) pg8::gemm_phase<pg8::EpiProj, pg8::StaticOrder, true, true>(lds, g, S, E, MY_TID());
            { constexpr int NT4 = (M / 256) * (NP / 256) - 3 * 256;
              if (l + 1 < DEPTH && gridDim.x == 256 && (int)blockIdx.x >= NT4) { WAVE_IDS();
                  p0_transposes((const float*)PTR(5), (const float*)PTR(6), (bf16*)(ws + WS_WIN), (bf16*)(ws + WS_WOUT), l + 1, (blockIdx.x - NT4) * NWAVES + wave, (256 - NT4) * NWAVES, lane); }
              else if (l + 1 < DEPTH && gridDim.x != 256) { WAVE_IDS(); p0_transposes((const float*)PTR(5), (const float*)PTR(6), (bf16*)(ws + WS_WIN), (bf16*)(ws + WS_WOUT), l + 1, gw, NGW, lane); } }
            GRID_BAR();
        }
        if (IN(pb + 2)) { WAVE_IDS(); unsigned char* ws = PTR(11);
#if NAIVE_RET
            if (blockIdx.x < 16) ret_naive_scan((const bf16*)(ws + WS_PROJ), (const float*)PTR(7) + l * 4, (const float*)PTR(8) + l * 4, (float*)(ws + WS_RET), lds, blockIdx.x, t__);
            __syncthreads();
#else
            REP(4) for (int u = blockIdx.x; u < NB * 4 * 32; u += gridDim.x) ret_chunk_state((const bf16*)(ws + WS_PROJ), (const float*)PTR(7) + l * 4, (const float*)PTR(8) + l * 4, (float*)(ws + WS_RET), lds, u, t__);
#endif
#if NAIVE_ATT
            attn_naive((const bf16*)(ws + WS_PROJ), (bf16*)(ws + WS_Y), lds, gw, NGW, wave, lane);
#else
            REP(8) for (int u = blockIdx.x; u < NB * 8 * 16; u += gridDim.x) attn_unit((const bf16*)(ws + WS_PROJ), (bf16*)(ws + WS_Y), ((u & 7) * 2 + ((u >> 3) >> 4 & 1)) * 16 + ((u >> 3) & 15), lds + wave * 16384, wave, lane);
#endif
            GRID_BAR();
        }
        if (IN(pb + 3)) { WAVE_IDS(); unsigned char* ws = PTR(11);
#if NAIVE_RET
            ret_naive_combine((const float*)(ws + WS_RET), (const bf16*)(ws + WS_PROJ), (bf16*)(ws + WS_Y), gw, NGW, lane);
#else
            REP(16) for (int gt = blockIdx.x * 512 + t__; gt < 16 * 8192; gt += gridDim.x * 512)
                ret_scan((const float*)(ws + WS_RET), (bf16*)(ws + WS_RET + 64 * MiB), (const float*)PTR(7) + l * 4, (const float*)PTR(8) + l * 4, gt);
            GRID_BAR();
            REP(32) for (int u = blockIdx.x; u < NB * 4 * 32; u += gridDim.x) ret_output((const bf16*)(ws + WS_PROJ), (const bf16*)(ws + WS_RET + 64 * MiB), (const float*)PTR(7) + l * 4, (const float*)PTR(8) + l * 4, (bf16*)(ws + WS_Y), lds, u, t__);
#endif
            GRID_BAR();
        }
        if (IN(pb + 4)) { unsigned char* ws = PTR(11);
            pg8::Gemm g{(const bf16*)(ws + WS_Y), (const bf16*)(ws + WS_WOUT) + (size_t)l * D * D, M, D, D}; pg8::StaticOrder S; S.init(M, D, gridDim.x, blockIdx.x);
            pg8::EpiResid E{(l == 0) ? (const float*)PTR(0) : (const float*)(ws + WS_X), (float*)(ws + WS_X), (const float*)(ws + WS_MOD) + (size_t)l * 2 * MODW + 2 * D, D, SEQ, MODW};
            for (int rep_ = 0; rep_ < (((REPEAT_MASK & 128) && l == 0) ? 2 : 1); ++rep_) pg8::gemm_phase<pg8::EpiResid, pg8::StaticOrder, true, true>(lds, g, S, E, MY_TID());
            GRID_BAR();
        }
    }
    if (IN(N_PHASES - 1)) { WAVE_IDS(); unsigned char* ws = PTR(11);
        norm_rows<true>((const float*)(ws + WS_X), (const float*)PTR(9), nullptr, nullptr, (float*)PTR(10), gw, NGW, lane); }
#undef IN
#undef GRID_BAR
}

extern "C" void kernel_launch(void* const* d_in, const int* in_sizes, int n_in, void* d_out, int out_size, void* d_ws, size_t ws_size, hipStream_t stream) {
    static int grid = 0;
    if (grid == 0) {
        if (n_in != 10 || out_size != M * D || ws_size < WS_END) { fprintf(stderr, "kernel_launch: unexpected shapes (n_in %d out %d ws %zu)\n", n_in, out_size, ws_size); grid = -1; return; }
        int dev = 0, cus = 0, per_cu = 0;
        hipGetDevice(&dev); hipDeviceGetAttribute(&cus, hipDeviceAttributeMultiprocessorCount, dev);
        if (hipFuncSetAttribute((const void*)fwd_kernel, hipFuncAttributeMaxDynamicSharedMemorySize, LDS_BYTES) != hipSuccess) { fprintf(stderr, "kernel_launch: hipFuncSetAttribute failed\n"); grid = -1; return; }
        if (hipOccupancyMaxActiveBlocksPerMultiprocessor(&per_cu, (const void*)fwd_kernel, NWAVES * 64, LDS_BYTES) != hipSuccess || per_cu < 1) { fprintf(stderr, "kernel_launch: occupancy query says %d\n", per_cu); per_cu = 1; }
        (void)hipGetLastError();
        grid = cus * 1;
        fprintf(stderr, "kernel_launch: grid %d (cus %d, per_cu %d)\n", grid, cus, per_cu);
    }
    if (grid < 0) return;
    Args a{};
    for (int i = 0; i < 10; ++i) a.in[i] = (const float*)d_in[i];
    a.out = (float*)d_out; a.ws = (unsigned char*)d_ws;
#if ONE_LAUNCH
    if (hipMemsetAsync((char*)d_ws + WS_CTL, 0, CTL_ZERO_BYTES, stream) != hipSuccess) { fprintf(stderr, "kernel_launch: memset failed\n"); return; }
    a.ph_lo = 0; a.ph_hi = N_PHASES; a.use_bar = 1;
    void* kargs[] = {&a};
    hipError_t e = hipLaunchCooperativeKernel((const void*)fwd_kernel, dim3(grid), dim3(NWAVES * 64), kargs, LDS_BYTES, stream);
    if (e != hipSuccess) fprintf(stderr, "kernel_launch: cooperative launch failed: %s (grid %d)\n", hipGetErrorString(e), grid);
#else
    for (int ph = 0; ph < N_PHASES; ++ph) {
        a.ph_lo = ph; a.ph_hi = ph + 1; a.use_bar = 0;
        hipLaunchKernelGGL(fwd_kernel, dim3(grid), dim3(NWAVES * 64), LDS_BYTES, stream, a);
    }
#endif
}
```
